# Optimizing an MI355X kernel written in HIP

```python
import functools
import jax, jax.numpy as jnp
from jax import lax
import numpy as np

D_MODEL = 1024
BATCH = 8
SEQ = 4096
DEPTH = 1
DEC_BATCH = 32
DEC_SEQ = 8
PAST_LEN = 16384
PAGE_SIZE = 128

N_HEADS = 8
N_KV_HEADS = 2
HEAD_DIM = 64
GQA_GROUP = N_HEADS // N_KV_HEADS
IDX_HEADS = 8
IDX_DIM = 64
TOPK_MAX = 256
Q_BLOCK = 128
GLA_HEADS = 4
GLA_DK_TOT = D_MODEL // 2
GLA_DV_TOT = D_MODEL
GLA_DK = GLA_DK_TOT // GLA_HEADS
GLA_DV = GLA_DV_TOT // GLA_HEADS
GATE_RANK = 16
GATE_TAU = 16.0
GLA_CHUNK = 64
D_FF = 4 * D_MODEL
NORM_EPS = 1e-5
DN_ALPHA = (2 * DEPTH) ** 0.25
DN_BETA = (8 * DEPTH) ** -0.25

PROJ_SPLITS = (
    ('q_a', N_HEADS * HEAD_DIM),
    ('k_a', N_KV_HEADS * HEAD_DIM),
    ('v_a', N_KV_HEADS * HEAD_DIM),
    ('q_i', IDX_HEADS * IDX_DIM),
    ('k_i', IDX_DIM),
    ('w_i', IDX_HEADS),
    ('q_b', GLA_DK_TOT),
    ('k_b', GLA_DK_TOT),
    ('v_b', GLA_DV_TOT),
    ('g_b', GLA_DV_TOT),
    ('a_b', GATE_RANK),
    ('gate_a', D_MODEL),
    ('gate_b', D_MODEL),
)
D_IN = (N_HEADS * HEAD_DIM + 2 * N_KV_HEADS * HEAD_DIM + IDX_HEADS * IDX_DIM + IDX_DIM + IDX_HEADS
        + 2 * GLA_DK_TOT + 2 * GLA_DV_TOT + GATE_RANK + 2 * D_MODEL)

kernel_name = 'dsa_gla_gated_hybrid_step'


def layer_norm(x, g, b):
    xf = x.astype(jnp.float32)
    xc = xf - jnp.mean(xf, -1, keepdims=True)
    var = jnp.mean(xc * xc, -1, keepdims=True)
    return (xc * lax.rsqrt(var + NORM_EPS) * g + b).astype(x.dtype)


def split_projection(z):
    parts = {}
    off = 0
    for name, width in PROJ_SPLITS:
        parts[name] = z[..., off:off + width]
        off += width
    return parts


def gather_rows(rows, idx):
    return jax.vmap(lambda r, i: r[i])(rows, idx)


def indexer_scores(q_idx, w_idx, k_idx):
    dots = jnp.einsum('bqhd,bsd->bqhs', q_idx, k_idx).astype(jnp.float32) * (IDX_DIM ** -0.5)
    w = w_idx.astype(jnp.float32) * (IDX_HEADS ** -0.5)
    return jnp.einsum('bqhs,bqh->bqs', jax.nn.relu(dots), w)


def select_keys(scores, q_pos, topk):
    k_pos = jnp.arange(scores.shape[-1])
    admissible = k_pos[None, None, :] <= q_pos[None, :, None]
    scores = jnp.where(admissible, scores, -jnp.inf)
    _, idx = lax.top_k(scores, topk)
    valid = idx <= q_pos[None, :, None]
    return idx, valid


def sparse_attend(q, k_sel, v_sel, valid):
    b, t = q.shape[:2]
    qg = q.reshape(b, t, N_KV_HEADS, GQA_GROUP, HEAD_DIM)
    s = jnp.einsum('bqkgd,bqskd->bqkgs', qg, k_sel).astype(jnp.float32) * (HEAD_DIM ** -0.5)
    s = jnp.where(valid[:, :, None, None, :], s, -jnp.inf)
    p = jax.nn.softmax(s, axis=-1).astype(v_sel.dtype)
    o = jnp.einsum('bqkgs,bqskd->bqkgd', p, v_sel)
    return o.reshape(b, t, N_HEADS * HEAD_DIM)


def dsa_prompt(q, k, v, q_idx, k_idx, w_idx):
    b, t = q.shape[:2]
    topk = min(TOPK_MAX, t // 4)
    qb = min(Q_BLOCK, t)

    def block(i):
        start = i * qb
        q_blk = lax.dynamic_slice_in_dim(q, start, qb, axis=1)
        qi_blk = lax.dynamic_slice_in_dim(q_idx, start, qb, axis=1)
        wi_blk = lax.dynamic_slice_in_dim(w_idx, start, qb, axis=1)
        q_pos = start + jnp.arange(qb)
        idx, valid = select_keys(indexer_scores(qi_blk, wi_blk, k_idx), q_pos, topk)
        return sparse_attend(q_blk, gather_rows(k, idx), gather_rows(v, idx), valid)

    o = lax.map(block, jnp.arange(t // qb))
    return o.transpose(1, 0, 2, 3).reshape(b, t, N_HEADS * HEAD_DIM)


def dsa_sample(q, k, v, q_idx, k_idx, w_idx, cache_k, cache_v, cache_kidx, page_table):
    b, t = q.shape[:2]
    past = page_table.shape[1] * PAGE_SIZE
    topk = min(TOPK_MAX, (past + t) // 4)
    k_idx_past = cache_kidx[page_table].reshape(b, past, IDX_DIM).astype(k_idx.dtype)
    k_idx_all = jnp.concatenate([k_idx_past, k_idx], axis=1)
    q_pos = past + jnp.arange(t)
    idx, valid = select_keys(indexer_scores(q_idx, w_idx, k_idx_all), q_pos, topk)
    in_past = (idx < past)[..., None, None]
    p_idx = jnp.minimum(idx, past - 1)
    phys = page_table[jnp.arange(b)[:, None, None], p_idx // PAGE_SIZE]
    off = p_idx % PAGE_SIZE
    n_idx = jnp.clip(idx - past, 0, t - 1)
    k_sel = jnp.where(in_past, cache_k[phys, off].astype(k.dtype), gather_rows(k, n_idx))
    v_sel = jnp.where(in_past, cache_v[phys, off].astype(v.dtype), gather_rows(v, n_idx))
    return sparse_attend(q, k_sel, v_sel, valid)


def gla_chunked(q, k, v, log_a, s0, chunk):
    b, t, h, _ = q.shape
    n = t // chunk

    def to_chunks(u):
        return u.astype(jnp.float32).reshape(b, n, chunk, h, -1).transpose(1, 0, 3, 2, 4)

    causal = jnp.tril(jnp.ones((chunk, chunk), dtype=bool))

    def step(s, inp):
        qx, kx, vx, ax = inp
        cum = jnp.cumsum(ax, axis=-2)
        last = cum[..., -1:, :]
        q_t = qx * jnp.exp(cum)
        k_t = kx * jnp.exp(-cum)
        att = jnp.where(causal, jnp.einsum('bhcd,bhed->bhce', q_t, k_t), 0.0)
        o = jnp.einsum('bhce,bhev->bhcv', att, vx) + jnp.einsum('bhcd,bhdv->bhcv', q_t, s)
        s = jnp.exp(last)[..., 0, :, None] * s + jnp.einsum('bhcd,bhcv->bhdv', kx * jnp.exp(last - cum), vx)
        return s, o

    s_fin, o = lax.scan(step, s0.astype(jnp.float32), (to_chunks(q), to_chunks(k), to_chunks(v), to_chunks(log_a)))
    o = o.transpose(1, 0, 3, 2, 4).reshape(b, t, h, v.shape[-1])
    return o, s_fin


def token_mixer(x, w_in, w_alpha2, b_alpha, gla_norm_g, w_attn_o, w_gla_o, w_out, attend, gla_s0, gla_chunk):
    b, t = x.shape[:2]
    z = split_projection(x @ w_in)
    q_a = z['q_a'].reshape(b, t, N_HEADS, HEAD_DIM)
    k_a = z['k_a'].reshape(b, t, N_KV_HEADS, HEAD_DIM)
    v_a = z['v_a'].reshape(b, t, N_KV_HEADS, HEAD_DIM)
    q_i = z['q_i'].reshape(b, t, IDX_HEADS, IDX_DIM)
    k_i = z['k_i']
    attn = attend(q_a, k_a, v_a, q_i, k_i, z['w_i'])
    log_a = jax.nn.log_sigmoid((z['a_b'] @ w_alpha2 + b_alpha).astype(jnp.float32)) / GATE_TAU
    q_b = z['q_b'].reshape(b, t, GLA_HEADS, GLA_DK) * (GLA_DK ** -0.5)
    k_b = z['k_b'].reshape(b, t, GLA_HEADS, GLA_DK)
    v_b = z['v_b'].reshape(b, t, GLA_HEADS, GLA_DV)
    o_b, s_new = gla_chunked(q_b, k_b, v_b, log_a.reshape(b, t, GLA_HEADS, GLA_DK), gla_s0, gla_chunk)
    o_b = o_b * lax.rsqrt(jnp.mean(o_b * o_b, -1, keepdims=True) + NORM_EPS) * gla_norm_g
    o_b = (o_b.reshape(b, t, GLA_DV_TOT) * jax.nn.silu(z['g_b'].astype(jnp.float32))).astype(x.dtype)
    branch_a = attn @ w_attn_o
    branch_b = o_b @ w_gla_o
    merged = jax.nn.sigmoid(z['gate_a']) * branch_a + jax.nn.sigmoid(z['gate_b']) * branch_b
    return merged @ w_out, k_a, v_a, k_i, s_new.astype(x.dtype)


def residual_block(x, mix_out, ln1_g, ln1_b, w_ff1, w_ff2, ln2_g, ln2_b):
    h = layer_norm(DN_ALPHA * x + mix_out, ln1_g, ln1_b)
    ff = jnp.square(jax.nn.relu(h @ w_ff1)) @ w_ff2
    return layer_norm(DN_ALPHA * h + ff, ln2_g, ln2_b)


def setup_inputs(seed: int = 0) -> dict:
    key = jax.random.key(seed)
    ks = jax.random.split(key, 24)
    f32 = jnp.float32
    n_pages = PAST_LEN // PAGE_SIZE
    used = DEC_BATCH * n_pages
    n_pool = used + max(1, used // 4)

    def nrm(k, shape, scale):
        return jax.random.normal(k, shape, f32) * scale

    page_table = jax.random.permutation(ks[0], n_pool)[:used].reshape(DEC_BATCH, n_pages).astype(jnp.int32)
    return {
        'x_prompt': nrm(ks[1], (BATCH, SEQ, D_MODEL), 1.0),
        'x_sample': nrm(ks[2], (DEC_BATCH, DEC_SEQ, D_MODEL), 1.0),
        'cache_k': nrm(ks[3], (DEPTH, n_pool, PAGE_SIZE, N_KV_HEADS, HEAD_DIM), 1.0),
        'cache_v': nrm(ks[4], (DEPTH, n_pool, PAGE_SIZE, N_KV_HEADS, HEAD_DIM), 1.0),
        'cache_kidx': nrm(ks[5], (DEPTH, n_pool, PAGE_SIZE, IDX_DIM), 1.0),
        'state_gla': nrm(ks[6], (DEPTH, DEC_BATCH, GLA_HEADS, GLA_DK, GLA_DV), 0.5),
        'page_table': page_table,
        'w_in': nrm(ks[7], (DEPTH, D_MODEL, D_IN), D_MODEL ** -0.5),
        'w_alpha2': nrm(ks[8], (DEPTH, GATE_RANK, GLA_DK_TOT), GATE_RANK ** -0.5),
        'b_alpha': nrm(ks[9], (DEPTH, GLA_DK_TOT), 0.1),
        'gla_norm_g': 1.0 + nrm(ks[10], (DEPTH, GLA_DV), 0.02),
        'w_attn_o': nrm(ks[11], (DEPTH, N_HEADS * HEAD_DIM, D_MODEL), (N_HEADS * HEAD_DIM) ** -0.5),
        'w_gla_o': nrm(ks[12], (DEPTH, GLA_DV_TOT, D_MODEL), GLA_DV_TOT ** -0.5),
        'w_out': nrm(ks[13], (DEPTH, D_MODEL, D_MODEL), DN_BETA * D_MODEL ** -0.5),
        'ln1_g': 1.0 + nrm(ks[14], (DEPTH, D_MODEL), 0.02),
        'ln1_b': nrm(ks[15], (DEPTH, D_MODEL), 0.02),
        'w_ff1': nrm(ks[16], (DEPTH, D_MODEL, D_FF), D_MODEL ** -0.5),
        'w_ff2': nrm(ks[17], (DEPTH, D_FF, D_MODEL), DN_BETA * D_FF ** -0.5),
        'ln2_g': 1.0 + nrm(ks[18], (DEPTH, D_MODEL), 0.02),
        'ln2_b': nrm(ks[19], (DEPTH, D_MODEL), 0.02),
    }


def reference(x_prompt, x_sample, cache_k, cache_v, cache_kidx, state_gla, page_table,
              w_in, w_alpha2, b_alpha, gla_norm_g, w_attn_o, w_gla_o, w_out,
              ln1_g, ln1_b, w_ff1, w_ff2, ln2_g, ln2_b):
    h_p, h_s = x_prompt, x_sample
    kp_l, vp_l, kip_l, sp_l = [], [], [], []
    ks_l, vs_l, kis_l, ss_l = [], [], [], []
    for l in range(DEPTH):
        mix_w = (w_in[l], w_alpha2[l], b_alpha[l], gla_norm_g[l], w_attn_o[l], w_gla_o[l], w_out[l])
        s0 = jnp.zeros((h_p.shape[0], GLA_HEADS, GLA_DK, GLA_DV), jnp.float32)
        m_p, k_p, v_p, ki_p, s_p = token_mixer(h_p, *mix_w, dsa_prompt, s0, min(GLA_CHUNK, h_p.shape[1]))
        attend_s = functools.partial(dsa_sample, cache_k=cache_k[l], cache_v=cache_v[l],
                                     cache_kidx=cache_kidx[l], page_table=page_table)
        m_s, k_s, v_s, ki_s, s_s = token_mixer(h_s, *mix_w, attend_s, state_gla[l], h_s.shape[1])
        h_p = residual_block(h_p, m_p, ln1_g[l], ln1_b[l], w_ff1[l], w_ff2[l], ln2_g[l], ln2_b[l])
        h_s = residual_block(h_s, m_s, ln1_g[l], ln1_b[l], w_ff1[l], w_ff2[l], ln2_g[l], ln2_b[l])
        kp_l.append(k_p); vp_l.append(v_p); kip_l.append(ki_p); sp_l.append(s_p)
        ks_l.append(k_s); vs_l.append(v_s); kis_l.append(ki_s); ss_l.append(s_s)
    return (h_p, h_s,
            jnp.stack(kp_l), jnp.stack(vp_l), jnp.stack(kip_l), jnp.stack(sp_l),
            jnp.stack(ks_l), jnp.stack(vs_l), jnp.stack(kis_l), jnp.stack(ss_l))
```

```cpp
#include <hip/hip_runtime.h>
#include <hip/hip_cooperative_groups.h>
#include <cstdio>
#include <cstdint>
namespace cg = cooperative_groups;

typedef unsigned short u16;
typedef short bf16x8 __attribute__((ext_vector_type(8)));
typedef _Float16 half8 __attribute__((ext_vector_type(8)));
typedef float f32x4 __attribute__((ext_vector_type(4)));
typedef float f32x16 __attribute__((ext_vector_type(16)));
typedef unsigned u32x4 __attribute__((ext_vector_type(4)));
typedef unsigned u32x2 __attribute__((ext_vector_type(2)));
#define LAS __attribute__((address_space(3)))

constexpr int DM = 1024, BATCH = 8, SEQ = 4096, DECB = 32, DECS = 8, PAST = 16384, PAGE = 128, NPAGES = 128;
constexpr int MP = BATCH * SEQ, MS = DECB * DECS, MT = MP + MS;
constexpr int TOPK = 256;
constexpr int DFF = 4096;
constexpr int DIN_SRC = 6488, ZW = 6656;
constexpr int QA_OFF = 0, KA_OFF = 512, VA_OFF = 640, QI_OFF = 768, KI_OFF = 1280, WI_OFF = 1344, AB_OFF = 1352, QB_OFF = 1536, KB_OFF = 2048,
              VB_OFF = 2560, GB_OFF = 3584, GA_OFF = 4608, GG_OFF = 5632;
__host__ __device__ __forceinline__ constexpr int gate_lo_off(int c) { return GA_OFF + 256 * (c >> 7) + (c & 127); }
constexpr float DN_ALPHA = 1.189207115002721f;
constexpr float NORM_EPS = 1e-5f;
constexpr float IDX_C = 0.125f * 0.35355339059327373f;
constexpr float QB_SCALE = 0.08838834764831845f;
constexpr float LOG2E = 1.4426950408889634f;
constexpr size_t OFF_Y = 0, OFF_KP = 33816576, OFF_VP = 38010880, OFF_KIP = 42205184, OFF_GP = 44302336, OFF_KS = 45350912, OFF_VS = 45383680,
                 OFF_KIS = 45416448, OFF_GS = 45432832, OUT_TOTAL = 49627136;
constexpr size_t MiB = 1u << 20;
constexpr size_t WS_CTL = 0, WS_WIN = 1 * MiB, WS_WAO = 14 * MiB, WS_WGO = 15 * MiB, WS_WOUT = 17 * MiB, WS_WF1 = 19 * MiB, WS_WF2 = 27 * MiB, WS_WI = 35 * MiB,
                 WS_AB = 37 * MiB, WS_DEC = 40 * MiB, WS_XB = 42 * MiB, WS_Z = 107 * MiB, WS_QT = 527 * MiB, WS_KDT = 560 * MiB, WS_ATT = 594 * MiB,
                 WS_SSC = 611 * MiB, WS_SSM = 739 * MiB, WS_ACAT = 756 * MiB, WS_ORAW = 853 * MiB, WS_T1 = 918 * MiB, WS_MRG = 983 * MiB, WS_U = 1048 * MiB,
                 WS_H1B = 1177 * MiB, WS_K8 = 1242 * MiB, WS_V8 = 1246 * MiB, WS_END = 1250 * MiB, WS_F = WS_Z, WS_SS = WS_T1  ;
constexpr size_t CTL_STAT = 65536, CTL_C1 = 393216, CTL_C2 = 409600, CTL_STAT2 = 458752, CTL_ZERO = 786432;
constexpr int SSTR = 16448;
constexpr int NCHUNK = 512 + 32;
constexpr int LDS_BYTES = 147456;
#ifndef PROBE_MODE
#define PROBE_MODE 0
#endif
#ifndef DUP_PHASE
#define DUP_PHASE 0
#endif
#define REP(n) for (int rep_ = 0; rep_ < ((DUP_PHASE == (n)) ? 2 : 1); ++rep_)

struct Params { const float* in[20]; float* out; unsigned char* ws; };
typedef __attribute__((address_space(4))) const char* kaptr_t;
typedef const float* cfptr_t; typedef float* fptr_t; typedef unsigned char* ucptr_t;
struct PA {
    kaptr_t ka; int wv;
    __device__ __forceinline__ kaptr_t base() const { kaptr_t b = ka; asm volatile("" : "+s"(b)); return b; }
    __device__ __forceinline__ const float* in(int i) const { return *(const __attribute__((address_space(4))) cfptr_t*)(base() + 8 * i); }
    __device__ __forceinline__ float* out() const { return *(const __attribute__((address_space(4))) fptr_t*)(base() + 160); }
    __device__ __forceinline__ unsigned char* ws() const { return *(const __attribute__((address_space(4))) ucptr_t*)(base() + 168); }
};

typedef float f32x2_cv __attribute__((ext_vector_type(2)));
typedef __bf16 bf16x2_cv __attribute__((ext_vector_type(2)));
__device__ __forceinline__ unsigned pk2bf(float lo, float hi) { const f32x2_cv v = {lo, hi}; const bf16x2_cv b = __builtin_convertvector(v, bf16x2_cv); return __builtin_bit_cast(unsigned, b); }
__device__ __forceinline__ unsigned f2bf(float f) { return pk2bf(f, 0.f) & 0xffffu; }
__device__ __forceinline__ float bf2f(unsigned short b) { return __builtin_bit_cast(float, (unsigned)b << 16); }
__device__ __forceinline__ float bflo(unsigned w) { return __builtin_bit_cast(float, w << 16); }
__device__ __forceinline__ float bfhi(unsigned w) { return __builtin_bit_cast(float, w & 0xffff0000u); }
__device__ __forceinline__ unsigned f2h(float f) { _Float16 h = (_Float16)f; return (unsigned)__builtin_bit_cast(unsigned short, h); }
__device__ __forceinline__ unsigned pk2h(float lo, float hi) { return f2h(lo) | (f2h(hi) << 16); }
__device__ __forceinline__ u32x2 pk8fp8(const f32x4 a, const f32x4 b) {
    int w0 = __builtin_amdgcn_cvt_pk_fp8_f32(a[0], a[1], 0, false); w0 = __builtin_amdgcn_cvt_pk_fp8_f32(a[2], a[3], w0, true);
    int w1 = __builtin_amdgcn_cvt_pk_fp8_f32(b[0], b[1], 0, false); w1 = __builtin_amdgcn_cvt_pk_fp8_f32(b[2], b[3], w1, true);
    return (u32x2){(unsigned)w0, (unsigned)w1};
}
__device__ __forceinline__ u32x2 fp8x4_to_bf16x4(unsigned w) {
    typedef float f32x2_ __attribute__((ext_vector_type(2)));
    const f32x2_ lo = __builtin_amdgcn_cvt_pk_f32_fp8((int)w, false), hi = __builtin_amdgcn_cvt_pk_f32_fp8((int)w, true);
    return (u32x2){(__float_as_uint(lo[0]) >> 16) | (__float_as_uint(lo[1]) & 0xffff0000u), (__float_as_uint(hi[0]) >> 16) | (__float_as_uint(hi[1]) & 0xffff0000u)};
}
__device__ __forceinline__ float sigmoidf_(float x) { return __builtin_amdgcn_rcpf(1.0f + __expf(-x)); }
__device__ __forceinline__ int lane_id() { int l; asm volatile("v_mbcnt_lo_u32_b32 %0, -1, 0\n\tv_mbcnt_hi_u32_b32 %0, -1, %0" : "=v"(l)); return l; }
__device__ __forceinline__ int fresh_tid(int wv) { int t = (wv << 6) | lane_id(); asm volatile("" : "+v"(t)); return t; }
__device__ __forceinline__ float wave_sum(float v) {
#pragma unroll
    for (int o = 1; o < 64; o <<= 1) v += __shfl_xor(v, o);
    return v;
}

#define XB_TMO      128
#define XB_XCNT(j)  (256  + 64 * (j))
#define XB_XSUB(j)  (1280 + 64 * (j))
#define XB_XGEN(j)  (2304 + 64 * (j))
#define XB_TOP      3328
#define XB_TOPGEN   3392
#define XCD_BAR_WORDS 3456
#define XB_SPIN_CAP (1u << 18)

__device__ __forceinline__ unsigned xb_ld(unsigned* p)              { return __hip_atomic_load(p, __ATOMIC_RELAXED, __HIP_MEMORY_SCOPE_AGENT); }
__device__ __forceinline__ unsigned xb_add(unsigned* p, unsigned v) { return __hip_atomic_fetch_add(p, v, __ATOMIC_RELAXED, __HIP_MEMORY_SCOPE_AGENT); }
__device__ __forceinline__ unsigned xb_xcc_id() { return (unsigned)__builtin_amdgcn_s_getreg((3 << 11) | 20) & 0xFu; }
#define XB_SPIN(cond, bar) do { unsigned _sp = 0; while (cond) { __builtin_amdgcn_s_sleep(1); \
    if ((++_sp & 255u) == 0u) { if (xb_ld(&(bar)[XB_TMO])) break; if (_sp > XB_SPIN_CAP) { atomicAdd(&(bar)[XB_TMO], 1u); break; } } } } while (0)

struct XcdBarrier {
    int wv; unsigned* bar; unsigned x;
    volatile LAS unsigned* st;
};

__device__ __forceinline__ XcdBarrier xcd_barrier_post(unsigned* bar, volatile LAS unsigned* st) {
    XcdBarrier b; b.wv = __builtin_amdgcn_readfirstlane(threadIdx.x >> 6); b.bar = bar; b.x = xb_xcc_id(); b.st = st;
    if (threadIdx.x == 0) (void)xb_add(&bar[XB_XCNT(b.x)], 1u);
    return b;
}
__device__ __forceinline__ void xcd_barrier_complete(unsigned* bar, unsigned x, unsigned& nloc, unsigned& nx) {
    const unsigned G = gridDim.x * gridDim.y * gridDim.z;
    unsigned sum, cnt, mine, sp = 0u;
    for (;;) {
        sum = 0u; cnt = 0u; mine = 0u;
#pragma unroll
        for (unsigned j = 0; j < 16; ++j) { const unsigned c = xb_ld(&bar[XB_XCNT(j)]); sum += c; cnt += (c > 0u) ? 1u : 0u; mine = (j == x) ? c : mine; }
        if (sum == G) break;
        __builtin_amdgcn_s_sleep(1);
        if ((++sp & 255u) == 0u) { if (xb_ld(&bar[XB_TMO])) break; if (sp > XB_SPIN_CAP) { atomicAdd(&bar[XB_TMO], 1u); break; } }
    }
    nloc = mine > 0u ? mine : 1u; nx = cnt > 0u ? cnt : 1u;
}

__device__ __forceinline__ void xcd_barrier(const XcdBarrier& b) {
    asm volatile("s_waitcnt vmcnt(0)" ::: "memory");
    __syncthreads();
    if (b.wv == 0 && lane_id() == 0) {
        unsigned* bar = b.bar;
        __builtin_amdgcn_s_waitcnt(0);
        unsigned nloc = b.st[0], nx = b.st[1];
        if (nloc == 0u) { xcd_barrier_complete(bar, b.x, nloc, nx); b.st[0] = nloc; b.st[1] = nx; }
        const unsigned old = xb_add(&bar[XB_XSUB(b.x)], 1u);
        const unsigned gen = old / nloc;
        if (old + 1u == (gen + 1u) * nloc) {
            __builtin_amdgcn_fence(__ATOMIC_RELEASE, "agent");
            asm volatile("s_waitcnt vmcnt(0)" ::: "memory");
            const unsigned og = xb_add(&bar[XB_TOP], 1u);
            const unsigned tg = og / nx;
            if (og + 1u == (tg + 1u) * nx) xb_add(&bar[XB_TOPGEN], 1u);
            else XB_SPIN(xb_ld(&bar[XB_TOPGEN]) == tg, bar);
            __builtin_amdgcn_fence(__ATOMIC_ACQUIRE, "agent");
            xb_add(&bar[XB_XGEN(b.x)], 1u);
            asm volatile("s_waitcnt vmcnt(0)" ::: "memory");
        } else {
            XB_SPIN(xb_ld(&bar[XB_XGEN(b.x)]) == gen, bar);
            __builtin_amdgcn_fence(__ATOMIC_ACQUIRE, "agent");
            asm volatile("s_waitcnt vmcnt(0)" ::: "memory");
        }
    }
    __syncthreads();
}


namespace pg8 {
typedef unsigned short bf16_t;
constexpr int BM = 256, BK = 64, HALF = 128, HTB = HALF * BK * 2, STAGE_BYTES = 8 * HTB, NXCD = 8, WGM = 4;
__host__ __device__ __forceinline__ int lds_byte(int r, int c) { const int st = (r >> 4) * 2 + (c >> 5), rr = r & 15, cc = c & 31, ob = rr * 64 + cc * 2; return st * 1024 + (ob ^ (((ob >> 9) & 1) << 5)); }
__host__ __device__ __forceinline__ void stage_rc(int b, int& R, int& C) { const int st = b / 1024, sb = b % 1024, swz = sb ^ (((sb >> 9) & 1) << 5); R = (st >> 1) * 16 + swz / 64; C = (st & 1) * 32 + (swz % 64) / 2; }
__host__ __device__ __forceinline__ int perm32(int rho) { const int n = rho >> 4, i = rho & 15; return 8 * (i >> 2) + 4 * n + (i & 3); }
struct Unit { int pm, pn; };
struct Gemm { const bf16_t* A; const bf16_t* Bt; int M, N, K, lda, ldb; };
struct StaticOrder {
    int nM, nN, nwg, G, c, wgm;
    __host__ __device__ void init(int M, int N, int G_, int c_, int wgm_ = WGM) { nM = M / BM; nN = N / BM; nwg = nM * nN; G = G_; c = c_; wgm = wgm_; }
    __host__ __device__ bool next(int i, Unit& u) const {
        const long L = (long)i * G + c; if (L >= nwg) return false;
        int wgid = (int)L; { const int q = nwg / NXCD, r = nwg % NXCD, xcd = wgid % NXCD, off = wgid / NXCD; wgid = (xcd < r ? xcd * (q + 1) : r * (q + 1) + (xcd - r) * q) + off; }
        const int nig = wgm * nN, gid = wgid / nig, fm = gid * wgm, gsz = (nM - fm) < wgm ? (nM - fm) : wgm;
        u.pm = fm + ((wgid % nig) % gsz); u.pn = (wgid % nig) / gsz; return true;
    }
};

template <class Epi, bool ALIGN_EPI>
__device__ __forceinline__ void gemm_phase(LAS unsigned char* lds, const Gemm g, const StaticOrder& S, const Epi& E, int wv) {
    int tid_ = (wv << 6) | lane_id(); asm volatile("" : "+v"(tid_));
    const int tid = tid_, wid = __builtin_amdgcn_readfirstlane(tid >> 6), lane = tid & 63, wr = wid >> 2, wc = wid & 3, fr = lane & 15, fq = lane >> 4;
    const int K = g.K, nt = K / BK;
    unsigned voffA[2], voffB[2];
#pragma unroll
    for (int i = 0; i < 2; ++i) { int R, C; stage_rc(tid * 16 + i * 8192, R, C); const int Rb = Epi::PERM ? ((R & ~31) + perm32(R & 31)) : R;
        voffA[i] = (unsigned)(R * g.lda + C) * 2u; voffB[i] = (unsigned)(Rb * g.ldb + C) * 2u; }
    const size_t kstep = (size_t)(BK * 2);
    const size_t hstepA = (size_t)HALF * g.lda * 2, hstepB = (size_t)HALF * g.ldb * 2;
    const size_t tstepA = 2 * hstepA, tstepB = 2 * hstepB;
    const unsigned ldsw = (unsigned)wid * 1024u;
    const int aoff = lds_byte(wr * 64 + fr, fq * 8), boff = lds_byte(wc * 32 + fr, fq * 8);
#define PG8_SA(b, h) (((b) * 2 + (h)) * HTB)
#define PG8_SB(b, h) ((4 + (b) * 2 + (h)) * HTB)
#define PG8_STAGE(bufoff, gbase, voff) do { _Pragma("unroll") for (int _i = 0; _i < 2; ++_i) \
        __builtin_amdgcn_global_load_lds((const unsigned*)((const char*)(gbase) + (voff)[_i]), (LAS unsigned*)(lds + (bufoff) + ldsw + _i * 8192), 16, 0, 0); } while (0)
#define PG8_LDA(dst, b, h) do { _Pragma("unroll") for (int m = 0; m < 4; ++m) _Pragma("unroll") for (int k = 0; k < 2; ++k) dst[m][k] = *(const LAS bf16x8*)(lds + PG8_SA(b, h) + aoff + m * 2048 + k * 1024); } while (0)
#define PG8_LDB(dst, b, h) do { _Pragma("unroll") for (int n = 0; n < 2; ++n) _Pragma("unroll") for (int k = 0; k < 2; ++k) dst[n][k] = *(const LAS bf16x8*)(lds + PG8_SB(b, h) + boff + n * 2048 + k * 1024); } while (0)
#define PG8_MMA(ai, bj, At, Bt) do { __builtin_amdgcn_s_setprio(1); _Pragma("unroll") for (int m = 0; m < 4; ++m) _Pragma("unroll") for (int n = 0; n < 2; ++n) _Pragma("unroll") for (int k = 0; k < 2; ++k) \
        acc[ai][bj][m][n] = __builtin_amdgcn_mfma_f32_16x16x32_bf16(Bt[n][k], At[m][k], acc[ai][bj][m][n], 0, 0, 0); __builtin_amdgcn_s_setprio(0); } while (0)
#define PG8_WAIT_V(n) asm volatile("s_waitcnt vmcnt(" #n ")" ::: "memory")
#define PG8_WAIT_L(n) asm volatile("s_waitcnt lgkmcnt(" #n ")" ::: "memory")
#define PG8_BAR __builtin_amdgcn_s_barrier()
#define PG8_SCHED __builtin_amdgcn_sched_barrier(0)
    Unit cur, nxt; int ui = 0;
    if (!S.next(0, cur)) return;
    if constexpr (Epi::UNIT_BEGIN) E.unit_begin(lds, cur, 0, tid);
    f32x4 acc[2][2][4][2];
#pragma unroll
    for (int a = 0; a < 2; ++a)
#pragma unroll
        for (int b = 0; b < 2; ++b)
#pragma unroll
            for (int m = 0; m < 4; ++m)
#pragma unroll
                for (int n = 0; n < 2; ++n) acc[a][b][m][n] = (f32x4){0.f, 0.f, 0.f, 0.f};
    const char* cA = (const char*)g.A + (size_t)cur.pm * tstepA; const char* cB = (const char*)g.Bt + (size_t)cur.pn * tstepB;
    PG8_STAGE(PG8_SB(0, 0), cB, voffB); PG8_STAGE(PG8_SB(0, 1), cB + hstepB, voffB); PG8_STAGE(PG8_SA(0, 0), cA, voffA); PG8_STAGE(PG8_SA(0, 1), cA + hstepA, voffA);
    if (wr == 1) PG8_BAR;
    PG8_WAIT_V(2); PG8_BAR;
    PG8_STAGE(PG8_SB(1, 0), cB + kstep, voffB); PG8_STAGE(PG8_SA(1, 0), cA + kstep, voffA); PG8_STAGE(PG8_SB(1, 1), cB + hstepB + kstep, voffB);
    PG8_WAIT_V(6); PG8_BAR;
    for (;;) {
        const bool has_next = S.next(ui + 1, nxt);
        const char* nA = has_next ? (const char*)g.A + (size_t)nxt.pm * tstepA : cA; const char* nB = has_next ? (const char*)g.Bt + (size_t)nxt.pn * tstepB : cB;
        constexpr int NSEG = Epi::HOOK_KT > 0 ? 1 + Epi::NHOOK : 1;
#define PG8_KBODY \
            bf16x8 At[4][2], B0[2][2], B1[2][2]; \
            const bool last = (t == nt - 2); \
            const char* a1 = cA + (size_t)(t + 1) * kstep; \
            const char* a2 = last ? nA : cA + (size_t)(t + 2) * kstep; const char* b2 = last ? nB : cB + (size_t)(t + 2) * kstep; \
            const char* a3 = a2 + kstep; const char* b3 = b2 + kstep; \
            PG8_LDB(B0, 0, 0); PG8_LDB(B1, 0, 1); PG8_SCHED; PG8_LDA(At, 0, 0); PG8_STAGE(PG8_SA(1, 1), a1 + hstepA, voffA); \
            PG8_WAIT_V(8); PG8_WAIT_L(0); PG8_BAR; PG8_MMA(0, 0, At, B0); PG8_MMA(0, 1, At, B1); PG8_BAR; PG8_SCHED; \
            PG8_LDA(At, 0, 1); PG8_STAGE(PG8_SB(0, 0), b2, voffB); PG8_STAGE(PG8_SB(0, 1), b2 + hstepB, voffB); PG8_STAGE(PG8_SA(0, 0), a2, voffA); \
            PG8_WAIT_V(8); PG8_WAIT_L(0); PG8_BAR; PG8_MMA(1, 0, At, B0); PG8_MMA(1, 1, At, B1); PG8_BAR; PG8_SCHED; \
            PG8_LDB(B0, 1, 0); PG8_LDB(B1, 1, 1); PG8_SCHED; PG8_LDA(At, 1, 0); PG8_STAGE(PG8_SA(0, 1), a2 + hstepA, voffA); \
            PG8_WAIT_V(8); PG8_WAIT_L(0); PG8_BAR; PG8_MMA(0, 0, At, B0); PG8_MMA(0, 1, At, B1); PG8_BAR; PG8_SCHED; \
            PG8_LDA(At, 1, 1); PG8_STAGE(PG8_SB(1, 0), b3, voffB); PG8_STAGE(PG8_SB(1, 1), b3 + hstepB, voffB); PG8_STAGE(PG8_SA(1, 0), a3, voffA); \
            PG8_WAIT_V(8); PG8_WAIT_L(0); PG8_BAR; PG8_MMA(1, 0, At, B0); PG8_MMA(1, 1, At, B1); PG8_BAR; PG8_SCHED;
        if constexpr (NSEG == 1) {
        for (int t = 0; t < nt; t += 2) { PG8_KBODY }
        } else {
#pragma unroll 1
        for (int seg = 0; seg < NSEG; ++seg) {
        if (seg >= 1) { PG8_SCHED; E.hook(seg - 1, ui, lds, acc, cur, wr, wc, fr, fq); PG8_SCHED; }
        const int tb = seg == 0 ? 0 : Epi::HOOK_KT + 4 * (seg - 1), te = seg == NSEG - 1 ? nt : Epi::HOOK_KT + 4 * seg;
        for (int t = tb; t < te; t += 2) { PG8_KBODY }
        }
        }
#undef PG8_KBODY
        if constexpr (ALIGN_EPI) { if (wr == 0) PG8_BAR; }
        if constexpr (Epi::UNIT_BEGIN) E.epi(ui, lds, acc, cur, wr, wc, fr, fq); else E(acc, cur, wr, wc, fr, fq);
        if (!has_next) break;
#pragma unroll
        for (int a = 0; a < 2; ++a)
#pragma unroll
            for (int b = 0; b < 2; ++b)
#pragma unroll
                for (int m = 0; m < 4; ++m)
#pragma unroll
                    for (int n = 0; n < 2; ++n) acc[a][b][m][n] = (f32x4){0.f, 0.f, 0.f, 0.f};
        cur = nxt; cA = nA; cB = nB; ++ui;
        if constexpr (Epi::UNIT_BEGIN) E.unit_begin(lds, cur, ui, tid);
        if constexpr (ALIGN_EPI) { if (wr == 1) PG8_BAR; }
    }
    PG8_WAIT_V(0);
    if constexpr (!ALIGN_EPI) { if (wr == 0) PG8_BAR; }
    PG8_BAR;
#undef PG8_SA
#undef PG8_SB
#undef PG8_STAGE
#undef PG8_LDA
#undef PG8_LDB
#undef PG8_MMA
#undef PG8_WAIT_V
#undef PG8_WAIT_L
#undef PG8_BAR
#undef PG8_SCHED
}
}

#define EPI_LOOP_ROWS _Pragma("unroll") for (int ai = 0; ai < 2; ++ai) _Pragma("unroll") for (int m = 0; m < 4; ++m)

struct EpiZ {
    static constexpr bool PERM = true; static constexpr int HOOK_KT = 0, NHOOK = 0; static constexpr bool UNIT_BEGIN = false;
    u16* Z; float* out; float* WI; float* AB; unsigned char* K8; unsigned char* V8; int ZS;
    template <int CLS>
    __device__ __forceinline__ void run(const f32x4 (&acc)[2][2][4][2], const pg8::Unit& u, int wr, int wc, int fr, int fq) const {
        const int row0 = u.pm * 256 + wr * 64 + fr, colt = u.pn * 256 + wc * 32 + 8 * fq;
        EPI_LOOP_ROWS {
            const int row = row0 + ai * 128 + m * 16;
#pragma unroll
            for (int bj = 0; bj < 2; ++bj) {
                const int col = colt + bj * 128; f32x4 v0 = acc[ai][bj][m][0], v1 = acc[ai][bj][m][1];
                if (CLS == 4) {
#pragma unroll
                    for (int e = 0; e < 4; ++e) { v0[e] *= sigmoidf_(v0[e]); v1[e] *= sigmoidf_(v1[e]); }
                }
                if (CLS == 3) {
                    if (col < WI_OFF) {
                        u32x4 w; w.x = pk2h(v0[0], v0[1]); w.y = pk2h(v0[2], v0[3]); w.z = pk2h(v1[0], v1[1]); w.w = pk2h(v1[2], v1[3]);
                        *(u32x4*)(Z + (size_t)row * ZS + col) = w;
                        float* o = out + OFF_KIP + (size_t)row * 64 + (col - KI_OFF);
                        *(f32x4*)o = v0; *(f32x4*)(o + 4) = v1;
                    } else if (col == WI_OFF) { float* o = WI + (size_t)row * 8; *(f32x4*)o = v0; *(f32x4*)(o + 4) = v1; }
                    else if (col < AB_OFF + 16) { float* o = AB + (size_t)row * 16 + (col - AB_OFF); *(f32x4*)o = v0; *(f32x4*)(o + 4) = v1; }
                } else if (CLS == 1) {
                    u32x4 w; w.x = pk2h(v0[0], v0[1]); w.y = pk2h(v0[2], v0[3]); w.z = pk2h(v1[0], v1[1]); w.w = pk2h(v1[2], v1[3]);
                    *(u32x4*)(Z + (size_t)row * ZS + col) = w;
                } else {
                    u32x4 w; w.x = pk2bf(v0[0], v0[1]); w.y = pk2bf(v0[2], v0[3]); w.z = pk2bf(v1[0], v1[1]); w.w = pk2bf(v1[2], v1[3]);
                    *(u32x4*)(Z + (size_t)row * ZS + col) = w;
                    if (CLS == 2) {
                        const int c = col - (bj ? VA_OFF : KA_OFF);
                        float* o = out + (bj ? OFF_VP : OFF_KP) + (size_t)row * 128 + c;
                        *(f32x4*)o = v0; *(f32x4*)(o + 4) = v1;
                        *(u32x2*)((bj ? V8 : K8) + (size_t)row * 128 + c) = pk8fp8(v0, v1);
                    }
                }
            }
        }
    }
    __device__ __forceinline__ void run_gates(const f32x4 (&acc)[2][2][4][2], const pg8::Unit& u, int wr, int wc, int fr, int fq) const {
        const int row0 = u.pm * 256 + wr * 64 + fr, colt = u.pn * 256 + wc * 32 + 8 * fq;
        EPI_LOOP_ROWS {
            const int row = row0 + ai * 128 + m * 16;
            float rho[8], sb[8];
#pragma unroll
            for (int e = 0; e < 8; ++e) {
                const float ga = acc[ai][0][m][e >> 2][e & 3], gg = acc[ai][1][m][e >> 2][e & 3];
                const float eb = __expf(fminf(-gg, 60.f)), ea = __expf(-ga);
                sb[e] = __builtin_amdgcn_rcpf(1.0f + eb); rho[e] = (1.0f + eb) * __builtin_amdgcn_rcpf(1.0f + ea);
            }
            u32x4 w0, w1;
            w0.x = pk2bf(rho[0], rho[1]); w0.y = pk2bf(rho[2], rho[3]); w0.z = pk2bf(rho[4], rho[5]); w0.w = pk2bf(rho[6], rho[7]);
            w1.x = pk2bf(sb[0], sb[1]); w1.y = pk2bf(sb[2], sb[3]); w1.z = pk2bf(sb[4], sb[5]); w1.w = pk2bf(sb[6], sb[7]);
            *(u32x4*)(Z + (size_t)row * ZS + colt) = w0; *(u32x4*)(Z + (size_t)row * ZS + colt + 128) = w1;
        }
    }
    __device__ __forceinline__ void operator()(const f32x4 (&acc)[2][2][4][2], const pg8::Unit& u, int wr, int wc, int fr, int fq) const {
        const int pn = u.pn;
        if (pn >= 18) run_gates(acc, u, wr, wc, fr, fq);
        else if (pn >= 14) run<4>(acc, u, wr, wc, fr, fq);
        else if (pn == 2) run<2>(acc, u, wr, wc, fr, fq); else if (pn == 5) run<3>(acc, u, wr, wc, fr, fq); else if (pn == 3 || pn == 4) run<1>(acc, u, wr, wc, fr, fq); else run<0>(acc, u, wr, wc, fr, fq);
    }
};
struct EpiGateA {
    static constexpr bool PERM = true; static constexpr int HOOK_KT = 0, NHOOK = 0; static constexpr bool UNIT_BEGIN = false;
    const u16* Z; u16* T1;
    __device__ __forceinline__ void operator()(const f32x4 (&acc)[2][2][4][2], const pg8::Unit& u, int wr, int wc, int fr, int fq) const {
        const int row0 = u.pm * 256 + wr * 64 + fr, colt = u.pn * 256 + wc * 32 + 8 * fq;
#pragma unroll
        for (int ai = 0; ai < 2; ++ai) {
            u32x4 gw[4][2];
#pragma unroll
            for (int m = 0; m < 4; ++m)
#pragma unroll
                for (int bj = 0; bj < 2; ++bj) gw[m][bj] = *(const u32x4*)(Z + (size_t)(row0 + ai * 128 + m * 16) * ZW + GA_OFF + colt + bj * 128);
#pragma unroll
            for (int m = 0; m < 4; ++m)
#pragma unroll
                for (int bj = 0; bj < 2; ++bj) {
                    const int row = row0 + ai * 128 + m * 16, col = colt + bj * 128; const f32x4 v0 = acc[ai][bj][m][0], v1 = acc[ai][bj][m][1];
                    const u32x4 g = gw[m][bj];
                    u32x4 w;
                    w.x = pk2bf(v0[0] * sigmoidf_(bflo(g.x)), v0[1] * sigmoidf_(bfhi(g.x))); w.y = pk2bf(v0[2] * sigmoidf_(bflo(g.y)), v0[3] * sigmoidf_(bfhi(g.y)));
                    w.z = pk2bf(v1[0] * sigmoidf_(bflo(g.z)), v1[1] * sigmoidf_(bfhi(g.z))); w.w = pk2bf(v1[2] * sigmoidf_(bflo(g.w)), v1[3] * sigmoidf_(bfhi(g.w)));
                    *(u32x4*)(T1 + (size_t)row * DM + col) = w;
                }
        }
    }
};
struct EpiGateB {
    static constexpr bool PERM = true; static constexpr int HOOK_KT = 0, NHOOK = 0; static constexpr bool UNIT_BEGIN = false;
    const u16* Z; const u16* T1; u16* MRG;
    __device__ __forceinline__ void operator()(const f32x4 (&acc)[2][2][4][2], const pg8::Unit& u, int wr, int wc, int fr, int fq) const {
        const int row0 = u.pm * 256 + wr * 64 + fr, colt = u.pn * 256 + wc * 32 + 8 * fq;
#pragma unroll
        for (int ai = 0; ai < 2; ++ai) {
            u32x4 gw[4][2], tw[4][2];
#pragma unroll
            for (int m = 0; m < 4; ++m)
#pragma unroll
                for (int bj = 0; bj < 2; ++bj) { const int row = row0 + ai * 128 + m * 16, col = colt + bj * 128;
                    gw[m][bj] = *(const u32x4*)(Z + (size_t)row * ZW + GG_OFF + col); tw[m][bj] = *(const u32x4*)(T1 + (size_t)row * DM + col); }
#pragma unroll
            for (int m = 0; m < 4; ++m)
#pragma unroll
                for (int bj = 0; bj < 2; ++bj) {
                    const int row = row0 + ai * 128 + m * 16, col = colt + bj * 128; const f32x4 v0 = acc[ai][bj][m][0], v1 = acc[ai][bj][m][1];
                    const u32x4 g = gw[m][bj], t = tw[m][bj];
                    u32x4 w;
                    w.x = pk2bf(bflo(t.x) + v0[0] * sigmoidf_(bflo(g.x)), bfhi(t.x) + v0[1] * sigmoidf_(bfhi(g.x)));
                    w.y = pk2bf(bflo(t.y) + v0[2] * sigmoidf_(bflo(g.y)), bfhi(t.y) + v0[3] * sigmoidf_(bfhi(g.y)));
                    w.z = pk2bf(bflo(t.z) + v1[0] * sigmoidf_(bflo(g.z)), bfhi(t.z) + v1[1] * sigmoidf_(bfhi(g.z)));
                    w.w = pk2bf(bflo(t.w) + v1[2] * sigmoidf_(bflo(g.w)), bfhi(t.w) + v1[3] * sigmoidf_(bfhi(g.w)));
                    *(u32x4*)(MRG + (size_t)row * DM + col) = w;
                }
        }
    }
};
struct EpiMerge {
    static constexpr bool PERM = true; static constexpr int HOOK_KT = 8, NHOOK = 4; static constexpr bool UNIT_BEGIN = true;
    const u16* Z; u16* MRG; const float* SS;
    static constexpr int FAC_OFF = 131072, FAC_BYTES = 5 * 256 * 4;
    __device__ __forceinline__ void unit_begin(LAS unsigned char* lds, const pg8::Unit& u, int ui, int tid) const {
        if (tid < 256) {
            const f32x4* ps = (const f32x4*)(SS + (size_t)(u.pm * 256 + tid) * 64);
            float v[4];
#pragma unroll
            for (int h = 0; h < 4; ++h) { const f32x4 a = ps[4 * h], b = ps[4 * h + 1], c = ps[4 * h + 2], d = ps[4 * h + 3];
                v[h] = ((a[0] + a[1] + a[2] + a[3]) + (b[0] + b[1] + b[2] + b[3]) + (c[0] + c[1] + c[2] + c[3]) + (d[0] + d[1] + d[2] + d[3])) * (1.0f / 256.0f) + NORM_EPS; }
            LAS float* fac = (LAS float*)(lds + FAC_OFF + (ui & 1) * FAC_BYTES);
            fac[tid] = __builtin_amdgcn_sqrtf(v[0]);
#pragma unroll
            for (int h = 1; h < 4; ++h) fac[h * 256 + tid] = __builtin_amdgcn_sqrtf(v[h] * __builtin_amdgcn_rcpf(v[h - 1]));
            fac[4 * 256 + tid] = __builtin_amdgcn_rsqf(v[3]);
        }
    }
    __device__ __forceinline__ void rowfac(int k, int ui, LAS unsigned char* lds, int wr, int fr, float (&f)[2][4]) const {
        const LAS float* fac = (const LAS float*)(lds + FAC_OFF + (ui & 1) * FAC_BYTES) + k * 256 + wr * 64 + fr;
        EPI_LOOP_ROWS { f[ai][m] = fac[ai * 128 + m * 16]; }
    }
    __device__ __forceinline__ void hook(int hi, int ui, LAS unsigned char* lds, f32x4 (&acc)[2][2][4][2], const pg8::Unit& u, int wr, int wc, int fr, int fq) const {
        const int row0 = u.pm * 256 + wr * 64 + fr, cg = 512 * u.pn + wc * 32 + 8 * fq;
        if (hi == 0) {
            const __amdgpu_buffer_rsrc_t zrs = __builtin_amdgcn_make_buffer_rsrc((void*)Z, 0, (int)((size_t)MT * ZW * 2), 0x00020000);
#pragma unroll
            for (int ai = 0; ai < 2; ++ai) {
                __builtin_amdgcn_sched_barrier(0);
                u32x4 rh[4][2];
#pragma unroll
                for (int m = 0; m < 4; ++m) { const unsigned vo = (unsigned)((row0 + ai * 128 + m * 16) * ZW + GA_OFF + cg) * 2u;
                    rh[m][0] = __builtin_amdgcn_raw_buffer_load_b128(zrs, vo, 0, 0); rh[m][1] = __builtin_amdgcn_raw_buffer_load_b128(zrs, vo + 512u, 0, 0); }
#pragma unroll
                for (int m = 0; m < 4; ++m)
#pragma unroll
                    for (int bj = 0; bj < 2; ++bj) {
                        const u32x4 a = rh[m][bj]; const unsigned aw[4] = {a.x, a.y, a.z, a.w};
#pragma unroll
                        for (int e = 0; e < 4; ++e) { acc[ai][bj][m][e >> 1][2 * (e & 1)] *= bflo(aw[e]); acc[ai][bj][m][e >> 1][2 * (e & 1) + 1] *= bfhi(aw[e]); }
                    }
            }
        }
        __builtin_amdgcn_sched_barrier(0);
        float f[2][4]; rowfac(hi, ui, lds, wr, fr, f);
        EPI_LOOP_ROWS {
#pragma unroll
            for (int bj = 0; bj < 2; ++bj) { acc[ai][bj][m][0] *= f[ai][m]; acc[ai][bj][m][1] *= f[ai][m]; }
        }
        __builtin_amdgcn_sched_barrier(0);
    }
    __device__ __forceinline__ void epi(int ui, LAS unsigned char* lds, const f32x4 (&acc)[2][2][4][2], const pg8::Unit& u, int wr, int wc, int fr, int fq) const {
        const int row0 = u.pm * 256 + wr * 64 + fr, colt = u.pn * 256 + wc * 32 + 8 * fq, cg = 512 * u.pn + wc * 32 + 8 * fq;
        float f[2][4]; rowfac(4, ui, lds, wr, fr, f);
#pragma unroll
        for (int ai = 0; ai < 2; ++ai) {
            u32x4 gw[4][2];
#pragma unroll
            for (int m = 0; m < 4; ++m)
#pragma unroll
                for (int bj = 0; bj < 2; ++bj) gw[m][bj] = *(const u32x4*)(Z + (size_t)(row0 + ai * 128 + m * 16) * ZW + GA_OFF + cg + 256 * bj + 128);
#pragma unroll
            for (int m = 0; m < 4; ++m)
#pragma unroll
                for (int bj = 0; bj < 2; ++bj) {
                    const int row = row0 + ai * 128 + m * 16, col = colt + bj * 128; const f32x4 v0 = acc[ai][bj][m][0] * f[ai][m], v1 = acc[ai][bj][m][1] * f[ai][m];
                    const u32x4 g = gw[m][bj];
                    u32x4 w;
                    w.x = pk2bf(v0[0] * bflo(g.x), v0[1] * bfhi(g.x)); w.y = pk2bf(v0[2] * bflo(g.y), v0[3] * bfhi(g.y));
                    w.z = pk2bf(v1[0] * bflo(g.z), v1[1] * bfhi(g.z)); w.w = pk2bf(v1[2] * bflo(g.w), v1[3] * bfhi(g.w));
                    *(u32x4*)(MRG + (size_t)row * DM + col) = w;
                }
        }
    }
};
__device__ __forceinline__ void row_stats(const float* STAT, int row, float& mean, float& rstd) {
    const f32x2_cv st = *(const f32x2_cv*)(STAT + (size_t)row * 2);
    mean = st[0] * (1.0f / DM); const float var = st[1] * (1.0f / DM) - mean * mean; rstd = 1.0f / sqrtf(var + NORM_EPS);
}
struct EpiU {
    static constexpr bool PERM = true; static constexpr int HOOK_KT = 0, NHOOK = 0; static constexpr bool UNIT_BEGIN = false;
    const u16* X; u16* UB; float* STAT;
    __device__ __forceinline__ void operator()(const f32x4 (&acc)[2][2][4][2], const pg8::Unit& u, int wr, int wc, int fr, int fq) const {
        const int row0 = u.pm * 256 + wr * 64 + fr, colt = u.pn * 256 + wc * 32 + 8 * fq;
#pragma unroll
        for (int ai = 0; ai < 2; ++ai) {
            u32x4 xw[4][2];
#pragma unroll
            for (int m = 0; m < 4; ++m)
#pragma unroll
                for (int bj = 0; bj < 2; ++bj) xw[m][bj] = *(const u32x4*)(X + (size_t)(row0 + ai * 128 + m * 16) * DM + colt + bj * 128);
#pragma unroll
            for (int m = 0; m < 4; ++m) {
                const int row = row0 + ai * 128 + m * 16;
                float s1 = 0.f, s2 = 0.f;
#pragma unroll
                for (int bj = 0; bj < 2; ++bj) {
                    const int col = colt + bj * 128;
                    const u32x4 xb = xw[m][bj];
                    const f32x4 x0 = (f32x4){bflo(xb.x), bfhi(xb.x), bflo(xb.y), bfhi(xb.y)}, x1 = (f32x4){bflo(xb.z), bfhi(xb.z), bflo(xb.w), bfhi(xb.w)};
                    const f32x4 u0 = x0 * DN_ALPHA + acc[ai][bj][m][0], u1 = x1 * DN_ALPHA + acc[ai][bj][m][1];
#pragma unroll
                    for (int e = 0; e < 4; ++e) { s1 += u0[e] + u1[e]; s2 += u0[e] * u0[e] + u1[e] * u1[e]; }
                    u32x4 w; w.x = pk2bf(u0[0], u0[1]); w.y = pk2bf(u0[2], u0[3]); w.z = pk2bf(u1[0], u1[1]); w.w = pk2bf(u1[2], u1[3]);
                    *(u32x4*)(UB + (size_t)row * DM + col) = w;
                }
                s1 += __shfl_xor(s1, 16); s1 += __shfl_xor(s1, 32); s2 += __shfl_xor(s2, 16); s2 += __shfl_xor(s2, 32);
                if (fq == 0) { atomicAdd(STAT + (size_t)row * 2, s1); atomicAdd(STAT + (size_t)row * 2 + 1, s2); }
            }
        }
    }
};
struct EpiRelu2LN {
    static constexpr bool PERM = true; static constexpr int HOOK_KT = 0, NHOOK = 0; static constexpr bool UNIT_BEGIN = false;
    u16* F; const float* STAT; const float* C1; const float* C2;
    __device__ __forceinline__ void operator()(const f32x4 (&acc)[2][2][4][2], const pg8::Unit& u, int wr, int wc, int fr, int fq) const {
        const int row0 = u.pm * 256 + wr * 64 + fr, colt = u.pn * 256 + wc * 32 + 8 * fq;
        f32x4 c1v[2][2], c2v[2][2];
#pragma unroll
        for (int bj = 0; bj < 2; ++bj)
#pragma unroll
            for (int n = 0; n < 2; ++n) { c1v[bj][n] = *(const f32x4*)(C1 + colt + bj * 128 + 4 * n); c2v[bj][n] = *(const f32x4*)(C2 + colt + bj * 128 + 4 * n); }
        float mean_[2][4], rstd_[2][4];
        EPI_LOOP_ROWS { row_stats(STAT, row0 + ai * 128 + m * 16, mean_[ai][m], rstd_[ai][m]); }
        EPI_LOOP_ROWS {
            const int row = row0 + ai * 128 + m * 16;
            const float mean = mean_[ai][m], rstd = rstd_[ai][m];
#pragma unroll
            for (int bj = 0; bj < 2; ++bj) {
                const int col = colt + bj * 128; f32x4 v0 = (acc[ai][bj][m][0] - c1v[bj][0] * mean) * rstd + c2v[bj][0], v1 = (acc[ai][bj][m][1] - c1v[bj][1] * mean) * rstd + c2v[bj][1];
#pragma unroll
                for (int e = 0; e < 4; ++e) { const float a = fmaxf(v0[e], 0.f), b = fmaxf(v1[e], 0.f); v0[e] = a * a; v1[e] = b * b; }
                u32x4 w; w.x = pk2bf(v0[0], v0[1]); w.y = pk2bf(v0[2], v0[3]); w.z = pk2bf(v1[0], v1[1]); w.w = pk2bf(v1[2], v1[3]);
                *(u32x4*)(F + (size_t)row * DFF + col) = w;
            }
        }
    }
};
struct EpiOut {
    static constexpr bool PERM = true; static constexpr int HOOK_KT = 0, NHOOK = 0; static constexpr bool UNIT_BEGIN = false;
    const u16* UB; const float* STAT; const float* G1; const float* B1; u16* VB; float* STAT2;
    __device__ __forceinline__ void operator()(const f32x4 (&acc)[2][2][4][2], const pg8::Unit& u, int wr, int wc, int fr, int fq) const {
        const int row0 = u.pm * 256 + wr * 64 + fr, colt = u.pn * 256 + wc * 32 + 8 * fq;
        f32x4 gv[2][2], bv[2][2];
#pragma unroll
        for (int bj = 0; bj < 2; ++bj)
#pragma unroll
            for (int n = 0; n < 2; ++n) { gv[bj][n] = *(const f32x4*)(G1 + colt + bj * 128 + 4 * n); bv[bj][n] = *(const f32x4*)(B1 + colt + bj * 128 + 4 * n); }
#pragma unroll
        for (int aq = 0; aq < 4; ++aq) {
            const int ai = aq >> 1;
            u32x4 uw[2][2]; float mean_[2], rstd_[2];
#pragma unroll
            for (int mm = 0; mm < 2; ++mm) { const int m = (aq & 1) * 2 + mm;
                row_stats(STAT, row0 + ai * 128 + m * 16, mean_[mm], rstd_[mm]);
#pragma unroll
                for (int bj = 0; bj < 2; ++bj) uw[mm][bj] = *(const u32x4*)(UB + (size_t)(row0 + ai * 128 + m * 16) * DM + colt + bj * 128); }
#pragma unroll
            for (int mm = 0; mm < 2; ++mm) {
                const int m = (aq & 1) * 2 + mm;
                const int row = row0 + ai * 128 + m * 16;
                const float mean = mean_[mm], rstd = rstd_[mm];
                float s1 = 0.f, s2 = 0.f;
#pragma unroll
                for (int bj = 0; bj < 2; ++bj) {
                    const int col = colt + bj * 128; const u32x4 ub = uw[mm][bj];
                    const f32x4 u0 = (f32x4){bflo(ub.x), bfhi(ub.x), bflo(ub.y), bfhi(ub.y)}, u1 = (f32x4){bflo(ub.z), bfhi(ub.z), bflo(ub.w), bfhi(ub.w)};
                    const f32x4 v0 = ((u0 - mean) * rstd * gv[bj][0] + bv[bj][0]) * DN_ALPHA + acc[ai][bj][m][0], v1 = ((u1 - mean) * rstd * gv[bj][1] + bv[bj][1]) * DN_ALPHA + acc[ai][bj][m][1];
#pragma unroll
                    for (int e = 0; e < 4; ++e) { s1 += v0[e] + v1[e]; s2 += v0[e] * v0[e] + v1[e] * v1[e]; }
                    u32x4 w; w.x = pk2bf(v0[0], v0[1]); w.y = pk2bf(v0[2], v0[3]); w.z = pk2bf(v1[0], v1[1]); w.w = pk2bf(v1[2], v1[3]);
                    *(u32x4*)(VB + (size_t)row * DM + col) = w;
                }
                s1 += __shfl_xor(s1, 16); s1 += __shfl_xor(s1, 32); s2 += __shfl_xor(s2, 16); s2 += __shfl_xor(s2, 32);
                if (fq == 0) { atomicAdd(STAT2 + (size_t)row * 2, s1); atomicAdd(STAT2 + (size_t)row * 2 + 1, s2); }
            }
        }
    }
};

template <class EpiEl, bool STATS = false>
__device__ __forceinline__ void mini_gemm(LAS unsigned char* lds, const u16* A, int lda, const u16* Bt, int ldb, int N, int K, const EpiEl& E, int vb, int G, int wv, float* STAT = nullptr, const float* SSROW = nullptr) {
    const int tid = fresh_tid(wv), lane = tid & 63, wave = __builtin_amdgcn_readfirstlane(tid >> 6), r = lane & 31, hh = lane >> 5;
    LAS float* red = (LAS float*)lds;
    const int ntiles = 8 * (N >> 5), kw = K >> 3;
    for (int t = vb; t < ntiles; t += G) {
        const int tm = t & 7, tn = t >> 3;
        const int lr = lane >> 3, lc = lane & 7;
        LAS unsigned char* wa = lds + 32768 + wave * (64 * 144); LAS unsigned char* wb = wa + 32 * 144;
        const u16* ap = A + (size_t)(32 * tm + lr) * lda + wave * kw + lc * 8;
        const u16* bp = Bt + (size_t)(32 * tn + lr) * ldb + wave * kw + lc * 8;
        u32x4 ra[4], rb[4];
#pragma unroll
        for (int i = 0; i < 4; ++i) { ra[i] = *(const u32x4*)(ap + (size_t)(8 * i) * lda); rb[i] = *(const u32x4*)(bp + (size_t)(8 * i) * ldb); }
        f32x16 acc = {};
#pragma unroll 1
        for (int kb = 0; kb < kw; kb += 64) {
#pragma unroll
            for (int i = 0; i < 4; ++i) { *(LAS u32x4*)(wa + (lr + 8 * i) * 144 + lc * 16) = ra[i]; *(LAS u32x4*)(wb + (lr + 8 * i) * 144 + lc * 16) = rb[i]; }
            const int kn = kb + 64 < kw ? kb + 64 : kb;
#pragma unroll
            for (int i = 0; i < 4; ++i) { ra[i] = *(const u32x4*)(ap + (size_t)(8 * i) * lda + kn); rb[i] = *(const u32x4*)(bp + (size_t)(8 * i) * ldb + kn); }
#pragma unroll
            for (int ks = 0; ks < 4; ++ks) {
                const bf16x8 a = *(const LAS bf16x8*)(wa + r * 144 + (16 * ks + 8 * hh) * 2), b = *(const LAS bf16x8*)(wb + r * 144 + (16 * ks + 8 * hh) * 2);
                acc = __builtin_amdgcn_mfma_f32_32x32x16_bf16(a, b, acc, 0, 0, 0);
            }
        }
        __syncthreads();
#pragma unroll
        for (int rg = 0; rg < 16; ++rg) red[(wave * 16 + rg) * 64 + lane] = acc[rg];
        __syncthreads();
#pragma unroll
        for (int i = 0; i < 2; ++i) {
            const int e = tid + 512 * i, rg = e >> 6, ln = e & 63; float s = 0.f;
            const int rs = 32 * tm + (rg & 3) + 8 * (rg >> 2) + 4 * (ln >> 5);
            if (SSROW) {
                const f32x4 ss = *(const f32x4*)(SSROW + (size_t)rs * 4);
#pragma unroll
                for (int w = 0; w < 8; ++w) s += red[(w * 16 + rg) * 64 + ln] * __builtin_amdgcn_rsqf(ss[w >> 1] * (1.0f / 256.0f) + NORM_EPS);
            } else {
#pragma unroll
            for (int w = 0; w < 8; ++w) s += red[(w * 16 + rg) * 64 + ln];
            }
            const float uv = E(rs, 32 * tn + (ln & 31), s);
            if (STATS) {
                float s1 = uv, s2 = uv * uv;
#pragma unroll
                for (int o = 1; o < 32; o <<= 1) { s1 += __shfl_xor(s1, o); s2 += __shfl_xor(s2, o); }
                if ((ln & 31) == 0) { atomicAdd(STAT + ((size_t)MP + rs) * 2, s1); atomicAdd(STAT + ((size_t)MP + rs) * 2 + 1, s2); }
            }
        }
    }
    __syncthreads();
}
template <class EpiEl>
__device__ __forceinline__ void mini_gemm64(LAS unsigned char* lds, const u16* A, int lda, const u16* Bt, int ldb, int N, int K, const EpiEl& E, int vb, int G, int wv) {
    const int tid = fresh_tid(wv), lane = tid & 63, wave = __builtin_amdgcn_readfirstlane(tid >> 6), r = lane & 31, hh = lane >> 5;
    LAS float* red = (LAS float*)lds;
    const int ntiles = 4 * (N >> 6), kh = K >> 1, qm = wave & 1, qn = (wave >> 1) & 1, khalf = wave >> 2;
    for (int t = vb; t < ntiles; t += G) {
        const int tm = t & 3, tn = t >> 2;
        const u16* ap = A + (size_t)(64 * tm + 32 * qm + r) * lda + khalf * kh + 8 * hh;
        const u16* bp = Bt + (size_t)(64 * tn + 32 * qn + r) * ldb + khalf * kh + 8 * hh;
        f32x16 acc = {};
#pragma unroll 8
        for (int k = 0; k < kh; k += 16) { const bf16x8 a = *(const bf16x8*)(ap + k), b = *(const bf16x8*)(bp + k); acc = __builtin_amdgcn_mfma_f32_32x32x16_bf16(a, b, acc, 0, 0, 0); }
        __syncthreads();
        if (khalf == 1) {
#pragma unroll
            for (int rg = 0; rg < 16; ++rg) red[((wave & 3) * 16 + rg) * 64 + lane] = acc[rg];
        }
        __syncthreads();
        if (khalf == 0) {
#pragma unroll
            for (int rg = 0; rg < 16; ++rg) {
                const float s = acc[rg] + red[((wave & 3) * 16 + rg) * 64 + lane];
                (void)E(64 * tm + 32 * qm + (rg & 3) + 8 * (rg >> 2) + 4 * hh, 64 * tn + 32 * qn + r, s);
            }
        }
    }
    __syncthreads();
}
template <class EpiEl>
__device__ __forceinline__ void mini_gemm_slab(LAS unsigned char* lds, const u16* A, int lda, const u16* Bt, int ldb, int N, int K, const EpiEl& E, int vb, int G, int wv) {
    const int tid = fresh_tid(wv), lane = tid & 63, wave = __builtin_amdgcn_readfirstlane(tid >> 6), r = lane & 31, hh = lane >> 5, lr = lane >> 3, lc = lane & 7;
    LAS unsigned char* wa = lds + wave * (64 * 144); LAS unsigned char* wb = wa + 32 * 144;
    const int nslab = N >> 5;
    for (int t = vb; t < nslab; t += G) {
        const u16* ap = A + (size_t)(32 * wave + lr) * lda + lc * 8;
        const u16* bp = Bt + (size_t)(32 * t + lr) * ldb + lc * 8;
        u32x4 ra[4], rb[4];
#pragma unroll
        for (int i = 0; i < 4; ++i) { ra[i] = *(const u32x4*)(ap + (size_t)(8 * i) * lda); rb[i] = *(const u32x4*)(bp + (size_t)(8 * i) * ldb); }
        f32x16 acc = {};
#pragma unroll 1
        for (int kb = 0; kb < K; kb += 64) {
#pragma unroll
            for (int i = 0; i < 4; ++i) { *(LAS u32x4*)(wa + (lr + 8 * i) * 144 + lc * 16) = ra[i]; *(LAS u32x4*)(wb + (lr + 8 * i) * 144 + lc * 16) = rb[i]; }
            const int kn = kb + 64 < K ? kb + 64 : kb;
#pragma unroll
            for (int i = 0; i < 4; ++i) { ra[i] = *(const u32x4*)(ap + (size_t)(8 * i) * lda + kn); rb[i] = *(const u32x4*)(bp + (size_t)(8 * i) * ldb + kn); }
#pragma unroll
            for (int ks = 0; ks < 4; ++ks) {
                const bf16x8 a = *(const LAS bf16x8*)(wa + r * 144 + (16 * ks + 8 * hh) * 2), b = *(const LAS bf16x8*)(wb + r * 144 + (16 * ks + 8 * hh) * 2);
                acc = __builtin_amdgcn_mfma_f32_32x32x16_bf16(a, b, acc, 0, 0, 0);
            }
        }
        LAS float* cl = (LAS float*)wa;
#pragma unroll
        for (int rg = 0; rg < 16; ++rg) cl[((rg & 3) + 8 * (rg >> 2) + 4 * hh) * 33 + r] = acc[rg];
#pragma unroll 1
        for (int e = 0; e < 16; ++e) { const int row = 2 * e + hh; (void)E(32 * wave + row, 32 * t + r, cl[row * 33 + r]); }
    }
    __syncthreads();
}
struct ElZ {
    u16* Z; float* out; float* WI; float* AB;
    __device__ __forceinline__ float operator()(int rs, int col, float v) const {
        const size_t row = (size_t)MP + rs;
        if (col >= KI_OFF && col < QB_OFF) {
            if (col < WI_OFF) { Z[row * ZW + col] = (u16)f2h(v); out[OFF_KIS + (size_t)rs * 64 + (col - KI_OFF)] = v; }
            else if (col < AB_OFF) WI[row * 8 + (col - WI_OFF)] = v;
            else if (col < AB_OFF + 16) AB[row * 16 + (col - AB_OFF)] = v;
        } else if (col >= QI_OFF && col < KI_OFF) Z[row * ZW + col] = (u16)f2h(v);
        else if (col >= GA_OFF) Z[row * ZW + col] = (u16)f2bf(sigmoidf_(v));
        else if (col >= GB_OFF) Z[row * ZW + col] = (u16)f2bf(v * sigmoidf_(v));
        else { Z[row * ZW + col] = (u16)f2bf(v);
            if (col >= KA_OFF && col < VA_OFF) out[OFF_KS + (size_t)rs * 128 + (col - KA_OFF)] = v;
            else if (col >= VA_OFF && col < QI_OFF) out[OFF_VS + (size_t)rs * 128 + (col - VA_OFF)] = v; }
        return 0.f;
    }
};
struct ElGateA { const u16* Z; u16* T1;
    __device__ __forceinline__ float operator()(int rs, int col, float v) const { const size_t row = (size_t)MP + rs; T1[row * DM + col] = (u16)f2bf(v * bf2f(Z[row * ZW + gate_lo_off(col)])); return 0.f; } };
struct ElGateB { const u16* Z; const u16* T1; u16* MRG;
    __device__ __forceinline__ float operator()(int rs, int col, float v) const { const size_t row = (size_t)MP + rs; MRG[row * DM + col] = (u16)f2bf(bf2f(T1[row * DM + col]) + v * bf2f(Z[row * ZW + gate_lo_off(col) + 128])); return 0.f; } };
struct ElU { const float* X; u16* UB;
    __device__ __forceinline__ float operator()(int rs, int col, float v) const { const float uu = X[(size_t)rs * DM + col] * DN_ALPHA + v; UB[((size_t)MP + rs) * DM + col] = (u16)f2bf(uu); return uu; } };
struct ElRelu2LN { u16* F; const float* STAT; const float* C1; const float* C2;
    __device__ __forceinline__ float operator()(int rs, int col, float v) const { float mean, rstd; row_stats(STAT, MP + rs, mean, rstd);
        const float a = fmaxf((v - mean * C1[col]) * rstd + C2[col], 0.f); F[((size_t)MP + rs) * DFF + col] = (u16)f2bf(a * a); return 0.f; } };
struct ElOut { const u16* UB; const float* STAT; const float* G1; const float* B1; u16* VB;
    __device__ __forceinline__ float operator()(int rs, int col, float v) const { float mean, rstd; row_stats(STAT, MP + rs, mean, rstd);
        const float h1 = (bf2f(UB[((size_t)MP + rs) * DM + col]) - mean) * rstd * G1[col] + B1[col]; const float vv = h1 * DN_ALPHA + v; VB[((size_t)MP + rs) * DM + col] = (u16)f2bf(vv); return vv; } };

__device__ __forceinline__ int win_src_col(int n) {
    if (n < AB_OFF) return n;
    if (n < AB_OFF + 16) return 4424 + (n - AB_OFF);
    if (n < QB_OFF) return -1;
    if (n < KB_OFF) return 1352 + (n - QB_OFF);
    if (n < VB_OFF) return 1864 + (n - KB_OFF);
    if (n < GB_OFF) return 2376 + (n - VB_OFF);
    if (n < GA_OFF) return 3400 + (n - GB_OFF);
    { const int t = n - GA_OFF, c = 128 * (t >> 8) + (t & 127); return ((t & 128) ? 5464 : 4440) + c; }
}
template <bool MAPPED>
__device__ __forceinline__ void transpose_item(const float* W, int K, int Nsrc, u16* WT, int nblk, LAS float* scr, int item, int lane, const float* kscale = nullptr, int ldw = 0, int kmask = -1) {
    if (ldw == 0) ldw = K;
    const int kb = item / nblk, nb = item % nblk, k0 = 64 * kb, n0 = 32 * nb;
    const int sc = MAPPED ? win_src_col(n0 + (lane & 31)) : n0 + (lane & 31);
    const int scc = sc >= 0 ? sc : 0;
#pragma unroll
    for (int ib = 0; ib < 32; ib += 16) {
        float wb[16];
#pragma unroll
        for (int i = 0; i < 16; ++i) wb[i] = W[(size_t)(k0 + 2 * (ib + i) + (lane >> 5)) * Nsrc + scc];
#pragma unroll
        for (int i = 0; i < 16; ++i) { const int kk = 2 * (ib + i) + (lane >> 5); float wv = wb[i]; if (MAPPED) { asm volatile("" : "+v"(wv)); if (sc < 0) wv = 0.f; }
            if (kscale) wv *= kscale[(k0 + kk) & kmask]; scr[kk * 33 + (lane & 31)] = wv; }
    }
    asm volatile("s_waitcnt lgkmcnt(0)" ::: "memory");
    const int c = lane & 7;
#pragma unroll
    for (int j = 0; j < 4; ++j) { const int n = (lane >> 3) + 8 * j; const LAS float* s = scr + (8 * c) * 33 + n;
        u32x4 o; o.x = pk2bf(s[0 * 33], s[1 * 33]); o.y = pk2bf(s[2 * 33], s[3 * 33]); o.z = pk2bf(s[4 * 33], s[5 * 33]); o.w = pk2bf(s[6 * 33], s[7 * 33]);
        *(u32x4*)(WT + (size_t)(n0 + n) * ldw + k0 + 8 * c) = o; }
    asm volatile("s_waitcnt lgkmcnt(0)" ::: "memory");
}
__device__ __forceinline__ void phase_prologue(const PA p, LAS unsigned char* lds) {
    const int tid = fresh_tid(p.wv), lane = tid & 63, wave = tid >> 6;
    LAS float* scr = (LAS float*)(lds + wave * 8448);
    const int gw = blockIdx.x * 8 + wave, NGW = gridDim.x * 8;
    unsigned char* ws = p.ws();
    constexpr int I_IN = 16 * (ZW / 32), I_AO = 8 * 32, I_GO = 16 * 32, I_OUT = 16 * 32, I_F1 = 16 * 128, I_F2 = 64 * 32;
    constexpr int NITEMS = I_IN + I_AO + I_GO + I_OUT + I_F1 + I_F2;
    for (int it = gw; it < NITEMS; it += NGW) {
        int r = it;
        if (r < I_IN) { transpose_item<true>(p.in(7), 1024, DIN_SRC, (u16*)(ws + WS_WIN), ZW / 32, scr, r, lane); continue; } r -= I_IN;
        if (r < I_AO) { transpose_item<false>(p.in(11), 512, 1024, (u16*)(ws + WS_WAO), 32, scr, r, lane, nullptr, 1536); continue; } r -= I_AO;
        if (r < I_GO) { transpose_item<false>(p.in(12), 1024, 1024, (u16*)(ws + WS_WAO) + 512, 32, scr, r, lane, p.in(10), 1536, 255); continue; } r -= I_GO;
        if (r < I_OUT) { transpose_item<false>(p.in(13), 1024, 1024, (u16*)(ws + WS_WOUT), 32, scr, r, lane); continue; } r -= I_OUT;
        if (r < I_F1) { transpose_item<false>(p.in(16), 1024, 4096, (u16*)(ws + WS_WF1), 128, scr, r, lane, p.in(14)); continue; } r -= I_F1;
        transpose_item<false>(p.in(17), 4096, 1024, (u16*)(ws + WS_WF2), 32, scr, r, lane);
    }
    u16* XB = (u16*)(ws + WS_XB);
    const float* const xprompt = p.in(0); const float* const xsample = p.in(1);
    for (int m = gw; m < MT; m += 4 * NGW) {
        f32x4 v[4][4];
#pragma unroll
        for (int k = 0; k < 4; ++k) { const int mk = m + k * NGW < MT ? m + k * NGW : m;
            const float* xr = mk < MP ? xprompt + (size_t)mk * DM : xsample + (size_t)(mk - MP) * DM; const f32x4* x4 = (const f32x4*)xr + lane;
#pragma unroll
            for (int j = 0; j < 4; ++j) v[k][j] = x4[64 * j]; }
#pragma unroll
        for (int k = 0; k < 4; ++k) {
            if (m + k * NGW >= MT) break;
            u32x2* o2 = (u32x2*)(XB + (size_t)(m + k * NGW) * DM) + lane;
#pragma unroll
            for (int j = 0; j < 4; ++j) { u32x2 o; o.x = pk2bf(v[k][j][0], v[k][j][1]); o.y = pk2bf(v[k][j][2], v[k][j][3]); o2[64 * j] = o; }
        }
    }
}

constexpr int GA_A = 0, GA_QT = 4096, GA_KT = GA_QT + 4 * 64 * 272, GA_END = GA_KT + 4 * 64 * 272;
static_assert(GA_END <= LDS_BYTES - 64, "GLA-A LDS map");
__device__ __forceinline__ void gla_a_chunk(const PA p, LAS unsigned char* lds, int cid) {
    const int tid = fresh_tid(p.wv), lane = tid & 63, wave = __builtin_amdgcn_readfirstlane(tid >> 6);
    unsigned char* ws = p.ws();
    const u16* Z = (const u16*)(ws + WS_Z); const float* AB = (const float*)(ws + WS_AB);
    u16* QT = (u16*)(ws + WS_QT); u16* KDT = (u16*)(ws + WS_KDT); u16* ATT = (u16*)(ws + WS_ATT); float* DEC = (float*)(ws + WS_DEC);
    const int R0 = cid < 512 ? cid * 64 : MP + (cid - 512) * 8, nv = cid < 512 ? 64 : 8;
    LAS float* a_l = (LAS float*)(lds + GA_A);
    const int h = tid >> 7, ch = tid & 127;
    LAS unsigned char* qt_l = lds + GA_QT + h * (64 * 272);
    LAS unsigned char* kt_l = lds + GA_KT + h * (64 * 272);
    __syncthreads();
    {
        u32x4 qraw[8], kraw[8];
#pragma unroll
        for (int i = 0; i < 8; ++i) { const int idx = tid + 512 * i, row = idx >> 6, c16 = idx & 63;
            if (row < nv) { const u16* zp = Z + (size_t)(R0 + row) * ZW + c16 * 8; qraw[i] = *(const u32x4*)(zp + QB_OFF); kraw[i] = *(const u32x4*)(zp + KB_OFF); }
            else { qraw[i] = (u32x4){0u, 0u, 0u, 0u}; kraw[i] = (u32x4){0u, 0u, 0u, 0u}; } }
        for (int i = tid; i < 1024; i += 512) { const int t = i >> 4; a_l[i] = t < nv ? AB[(size_t)(R0 + t) * 16 + (i & 15)] : 0.f; }
#pragma unroll
        for (int i = 0; i < 8; ++i) { const int idx = tid + 512 * i, row = idx >> 6, c16 = idx & 63; const int off = (c16 >> 4) * (64 * 272) + row * 272 + (c16 & 15) * 16;
            *(LAS u32x4*)(lds + GA_QT + off) = qraw[i]; *(LAS u32x4*)(lds + GA_KT + off) = kraw[i]; }
    }
    float w2[16];
#pragma unroll
    for (int r = 0; r < 16; ++r) w2[r] = p.in(8)[r * 512 + h * 128 + ch];
    const float bias = p.in(9)[h * 128 + ch];
    __syncthreads();
    float cum[64]; float run = 0.f;
#pragma unroll
    for (int t = 0; t < 64; ++t) {
        float x = bias;
#pragma unroll
        for (int r4 = 0; r4 < 4; ++r4) { const f32x4 a = *(const LAS f32x4*)(a_l + t * 16 + r4 * 4); x += a[0] * w2[r4 * 4] + a[1] * w2[r4 * 4 + 1] + a[2] * w2[r4 * 4 + 2] + a[3] * w2[r4 * 4 + 3]; }
        float la = (fminf(x, 0.f) - __logf(1.0f + __expf(-fabsf(x)))) * (1.0f / 16.0f);
        if (t >= nv) la = 0.f;
        run += la; cum[t] = run;
    }
    const float last = run; const float elast = __expf(last);
    u16* kdp = KDT + (((size_t)cid * 4 + h) * 128 + ch) * 64;
#pragma unroll
    for (int t8 = 0; t8 < 8; ++t8) {
        unsigned kd[4];
#pragma unroll
        for (int tt = 0; tt < 8; ++tt) {
            const int t = t8 * 8 + tt; const float c = cum[t];
            const float q = bf2f(*(const LAS u16*)(qt_l + t * 272 + ch * 2)), k = bf2f(*(const LAS u16*)(kt_l + t * 272 + ch * 2));
            const float ec = __expf(c), iec = __builtin_amdgcn_rcpf(ec); const float qt = q * QB_SCALE * ec, kt = k * iec, kdv = kt * elast;
            *(LAS u16*)(qt_l + t * 272 + ch * 2) = (u16)f2bf(qt);
            *(LAS u16*)(kt_l + t * 272 + ch * 2) = (u16)f2bf(kt);
            const unsigned kb = f2bf(kdv);
            if (tt & 1) kd[tt >> 1] |= kb << 16; else kd[tt >> 1] = kb;
        }
        *(u32x4*)(kdp + t8 * 8) = (u32x4){kd[0], kd[1], kd[2], kd[3]};
    }
    DEC[((size_t)cid * 4 + h) * 128 + ch] = elast;
    __syncthreads();
#pragma unroll
    for (int i = 0; i < 8; ++i) { const int idx = tid + 512 * i, row = idx >> 6, c16 = idx & 63;
        if (row < nv) *(u32x4*)(QT + (size_t)(R0 + row) * 512 + c16 * 8) = *(const LAS u32x4*)(lds + GA_QT + (c16 >> 4) * (64 * 272) + row * 272 + (c16 & 15) * 16); }
    for (int job = wave; job < 12; job += 8) {
        const int hj = job / 3, tl = job - 3 * hj, ti = tl == 0 ? 0 : 1, tj = tl == 2 ? 1 : 0, r = lane & 31, hh = lane >> 5;
        const LAS unsigned char* qh = lds + GA_QT + hj * (64 * 272); const LAS unsigned char* kh = lds + GA_KT + hj * (64 * 272);
        f32x16 acc = {};
#pragma unroll
        for (int ks = 0; ks < 8; ++ks) {
            const bf16x8 a = *(const LAS bf16x8*)(qh + (32 * ti + r) * 272 + (16 * ks + 8 * hh) * 2);
            const bf16x8 bb = *(const LAS bf16x8*)(kh + (32 * tj + r) * 272 + (16 * ks + 8 * hh) * 2);
            acc = __builtin_amdgcn_mfma_f32_32x32x16_bf16(a, bb, acc, 0, 0, 0);
        }
        u16* ap = ATT + ((size_t)cid * 4 + hj) * 4096;
        const int j = 32 * tj + r;
#pragma unroll
        for (int rg = 0; rg < 16; ++rg) { const int i = 32 * ti + (rg & 3) + 8 * (rg >> 2) + 4 * hh; ap[i * 64 + j] = (u16)f2bf(j <= i ? acc[rg] : 0.f); }
    }
}

constexpr int SS_GRP = 3, SS_ITEMS = DECB * ((NPAGES + 1) / SS_GRP);
static_assert((NPAGES + 1) % SS_GRP == 0, "page groups");
__device__ __forceinline__ void sample_scores_tile(const half8 (&af)[2][4], const float (&wv)[2][16], const half8 (&bfr)[4], float* srow, int r, int hh) {
#pragma unroll
    for (int rb = 0; rb < 2; ++rb) {
        f32x16 acc = {};
#pragma unroll
        for (int ks = 0; ks < 4; ++ks) acc = __builtin_amdgcn_mfma_f32_32x32x16_f16(af[rb][ks], bfr[ks], acc, 0, 0, 0);
#pragma unroll
        for (int tl = 0; tl < 4; ++tl) {
            float s = 0.f;
#pragma unroll
            for (int e = 0; e < 4; ++e) s = fmaf(fmaxf(acc[4 * tl + e], 0.f), wv[rb][4 * tl + e], s);
            s += __shfl_xor(s, 32);
            if (hh == 0) srow[(size_t)(4 * rb + tl) * SSTR + r] = s;
        }
    }
}
__device__ __forceinline__ void sample_scores_phase(const PA p, int lane) {
    unsigned char* ws = p.ws();
    const u16* Z = (const u16*)(ws + WS_Z); const float* WI = (const float*)(ws + WS_WI); float* SSM = (float*)(ws + WS_SSM);
    const int* ptab = (const int*)p.in(6);
    unsigned* ctr = (unsigned*)(ws + WS_CTL + 32768);
    const int r = lane & 31, hh = lane >> 5;
    int cur_bs = -1;
    half8 af[2][4]; float wv[2][16];
    for (;;) {
        unsigned it = 0u; if (lane == 0) it = atomicAdd(ctr, 1u);
        it = (unsigned)__builtin_amdgcn_readfirstlane((int)it);
        if (it >= (unsigned)SS_ITEMS) break;
        const int bs = (int)it / ((NPAGES + 1) / SS_GRP), pg0 = ((int)it % ((NPAGES + 1) / SS_GRP)) * SS_GRP;
        if (bs != cur_bs) {
            cur_bs = bs;
#pragma unroll
            for (int rb = 0; rb < 2; ++rb) {
                const int tok = 4 * rb + (r >> 3), head = r & 7;
                const u16* qp = Z + (size_t)(MP + bs * 8 + tok) * ZW + QI_OFF + head * 64 + 8 * hh;
#pragma unroll
                for (int ks = 0; ks < 4; ++ks) af[rb][ks] = *(const half8*)(qp + 16 * ks);
#pragma unroll
                for (int tl = 0; tl < 4; ++tl) { const f32x4 w4 = *(const f32x4*)(WI + (size_t)(MP + bs * 8 + 4 * rb + tl) * 8 + 4 * hh);
#pragma unroll
                    for (int e = 0; e < 4; ++e) wv[rb][4 * tl + e] = w4[e] * IDX_C; }
            }
        }
#pragma unroll 1
        for (int pg = pg0; pg < pg0 + SS_GRP; ++pg) {
            float* srow = SSM + (size_t)(bs * 8) * SSTR + pg * PAGE;
            if (pg < NPAGES) {
                const float* kp = p.in(4) + ((size_t)ptab[bs * NPAGES + pg] * PAGE + r) * 64 + 8 * hh;
                f32x4 x[4][4][2];
#pragma unroll
                for (int kt = 0; kt < 4; ++kt)
#pragma unroll
                    for (int ks = 0; ks < 4; ++ks) { x[kt][ks][0] = *(const f32x4*)(kp + kt * 32 * 64 + 16 * ks); x[kt][ks][1] = *(const f32x4*)(kp + kt * 32 * 64 + 16 * ks + 4); }
#pragma unroll
                for (int kt = 0; kt < 4; ++kt) {
                    half8 bfr[4];
#pragma unroll
                    for (int ks = 0; ks < 4; ++ks) { const f32x4 x0 = x[kt][ks][0], x1 = x[kt][ks][1];
                        bfr[ks] = (half8){(_Float16)x0[0], (_Float16)x0[1], (_Float16)x0[2], (_Float16)x0[3], (_Float16)x1[0], (_Float16)x1[1], (_Float16)x1[2], (_Float16)x1[3]}; }
                    sample_scores_tile(af, wv, bfr, srow + kt * 32, r, hh);
                }
            } else {
                half8 bfr[4];
                const u16* kp = Z + (size_t)(MP + bs * 8 + (r & 7)) * ZW + KI_OFF + 8 * hh;
#pragma unroll
                for (int ks = 0; ks < 4; ++ks) bfr[ks] = *(const half8*)(kp + 16 * ks);
                sample_scores_tile(af, wv, bfr, srow, r, hh);
            }
        }
    }
}

__device__ __forceinline__ unsigned okey(float f) { unsigned u = __builtin_bit_cast(unsigned, f); if (u == 0x80000000u) u = 0u; return (u & 0x80000000u) ? ~u : (u | 0x80000000u); }
__device__ __forceinline__ void hist_find(const LAS unsigned* hist, int bpl, int r, int lane, unsigned& dsel, unsigned& cab) {
    unsigned tot = 0u;
    for (int j = 0; j < bpl; ++j) tot += hist[lane * bpl + j];
    unsigned suf = tot;
#pragma unroll
    for (int o = 1; o < 64; o <<= 1) { const unsigned t = __shfl_down(suf, o); if (lane + o < 64) suf += t; }
    const unsigned above = suf - tot;
    const bool mine = (above < (unsigned)r) && ((unsigned)r <= above + tot);
    unsigned d = 0u, cb = 0u;
    if (mine) { unsigned cumv = above; for (int j = bpl - 1; j >= 0; --j) { const unsigned cnt = hist[lane * bpl + j]; if (cumv + cnt >= (unsigned)r) { d = (unsigned)(lane * bpl + j); cb = cumv; break; } cumv += cnt; } }
    const unsigned long long bm = __ballot(mine);
    const int src = __ffsll((long long)bm) - 1;
    dsel = (unsigned)__shfl((int)d, src); cab = (unsigned)__shfl((int)cb, src);
}
__device__ __forceinline__ int select_topk_block(const float* scores, int n, LAS unsigned* hist, LAS unsigned* sel, LAS unsigned* xch, int tid) {
    const int lane = tid & 63, wave = __builtin_amdgcn_readfirstlane(tid >> 6);
    constexpr int SEG = 33 * 64;
    unsigned key[33];
    {
        float sv[33];
#pragma unroll
        for (int c = 0; c < 33; ++c) { const int i = wave * SEG + c * 64 + lane; sv[c] = scores[i < n ? i : n - 1]; }
#pragma unroll
        for (int c = 0; c < 33; ++c) { const int i = wave * SEG + c * 64 + lane; float v = sv[c]; asm volatile("" : "+v"(v)); key[c] = i < n ? okey(v) : 0u; }
    }
    unsigned prefix = 0u, pmask = 0u; int r = TOPK;
#pragma unroll 1
    for (int level = 0; level < 3; ++level) {
        const int shift = level == 0 ? 21 : (level == 1 ? 10 : 0), nb = level == 2 ? 1024 : 2048;
        const unsigned bmask = (unsigned)(nb - 1);
        for (int i = tid; i < 2048; i += 512) hist[i] = 0u;
        __syncthreads();
#pragma unroll
        for (int c = 0; c < 33; ++c) { const unsigned k = key[c]; if ((k & pmask) == prefix) atomicAdd((unsigned*)(hist + ((k >> shift) & bmask)), 1u); }
        __syncthreads();
        if (wave == 0) { unsigned dsel, cab; hist_find(hist, nb >> 6, r, lane, dsel, cab); if (lane == 0) { xch[0] = dsel; xch[1] = cab; } }
        __syncthreads();
        const unsigned dsel = xch[0], cab = xch[1];
        prefix |= dsel << shift; pmask |= bmask << shift; r -= (int)cab;
    }
    int cgt = 0, ceq = 0;
#pragma unroll
    for (int c = 0; c < 33; ++c) { const unsigned k = key[c]; cgt += __popcll(__ballot(k > prefix)); ceq += __popcll(__ballot(k == prefix)); }
    if (lane == 0) { xch[2 + wave] = (unsigned)cgt; xch[10 + wave] = (unsigned)ceq; }
    __syncthreads();
    int pos = 0, eqt = 0;
    for (int w2 = 0; w2 < wave; ++w2) { const int g2 = (int)xch[2 + w2], e2 = (int)xch[10 + w2]; int te = r - eqt; te = te < 0 ? 0 : (te > e2 ? e2 : te); pos += g2 + te; eqt += e2; }
    const unsigned long long ltm = (1ull << lane) - 1ull;
#pragma unroll
    for (int c = 0; c < 33; ++c) {
        const unsigned k = key[c]; const bool gt = k > prefix, eq = k == prefix;
        const unsigned long long em = __ballot(eq);
        const bool take = gt || (eq && (eqt + __popcll(em & ltm) < r));
        const unsigned long long tm = __ballot(take);
        if (take) { const int pp = pos + __popcll(tm & ltm); if (pp < TOPK) sel[pp] = (unsigned)(wave * SEG + c * 64 + lane); }
        pos += __popcll(tm); eqt += __popcll(em);
    }
    __syncthreads();
    return TOPK;
}

struct KVPrompt {
    const u16* Z; size_t row0;
    __device__ __forceinline__ bf16x8 k8(int key, int g, int d) const { return *(const bf16x8*)(Z + (row0 + key) * ZW + KA_OFF + g * 64 + d); }
    __device__ __forceinline__ bf16x8 v8(int key, int g, int d) const { return *(const bf16x8*)(Z + (row0 + key) * ZW + VA_OFF + g * 64 + d); }
};
__device__ __forceinline__ bf16x8 cvt8(const float* p) {
    const f32x4 a = *(const f32x4*)p, b = *(const f32x4*)(p + 4); u32x4 w; w.x = pk2bf(a[0], a[1]); w.y = pk2bf(a[2], a[3]); w.z = pk2bf(b[0], b[1]); w.w = pk2bf(b[2], b[3]);
    return __builtin_bit_cast(bf16x8, w);
}
struct KVSample {
    const float* ck; const float* cv; const float* nk; const float* nv; const int* pt;
    __device__ __forceinline__ unsigned code(int key) const { return key < PAST ? (unsigned)(pt[key >> 7] * PAGE + (key & 127)) : (0x80000000u | (unsigned)(key - PAST)); }
    __device__ __forceinline__ const float* rowp(const float* cache, const float* nw, int c) const {
        return c >= 0 ? cache + (size_t)c * 128 : nw + (size_t)(c & 0x7fffffff) * 128; }
    __device__ __forceinline__ bf16x8 k8(int key, int g, int d) const { return cvt8(rowp(ck, nk, key) + g * 64 + d); }
    __device__ __forceinline__ bf16x8 v8(int key, int g, int d) const { return cvt8(rowp(cv, nv, key) + g * 64 + d); }
};
template <class KV, int QKB, int PVB>
__device__ __forceinline__ void sparse_attn_g(const u16* zq, const KV& kv, const LAS unsigned* sel, int count, LAS float* pbuf, u16* orow, int lane, int g) {
    const int col = lane & 15, kq = lane >> 4;
    bf16x8 bq0 = {}, bq1 = {};
    if (col < 4) { const u16* qp = zq + QA_OFF + (4 * g + col) * 64 + 8 * kq; bq0 = *(const bf16x8*)qp; bq1 = *(const bf16x8*)(qp + 32); }
    float mx = -INFINITY;
#pragma unroll 1
    for (int jb = 0; jb < 16; jb += QKB) {
        bf16x8 ka[QKB][2];
#pragma unroll
        for (int j = 0; j < QKB; ++j) { const int key = (int)sel[16 * (jb + j) + col]; ka[j][0] = kv.k8(key, g, 8 * kq); ka[j][1] = kv.k8(key, g, 32 + 8 * kq); }
#pragma unroll
        for (int j = 0; j < QKB; ++j) {
            f32x4 acc = {};
            acc = __builtin_amdgcn_mfma_f32_16x16x32_bf16(ka[j][0], bq0, acc, 0, 0, 0);
            acc = __builtin_amdgcn_mfma_f32_16x16x32_bf16(ka[j][1], bq1, acc, 0, 0, 0);
#pragma unroll
            for (int e = 0; e < 4; ++e) { const int slot = 16 * (jb + j) + 4 * kq + e; const float v = slot < count ? acc[e] * (0.125f * LOG2E) : -INFINITY; mx = fmaxf(mx, v);
                if (col < 4) pbuf[slot * 4 + col] = v; }
        }
    }
    mx = fmaxf(mx, __shfl_xor(mx, 16)); mx = fmaxf(mx, __shfl_xor(mx, 32));
    float mh[4], sh[4];
#pragma unroll
    for (int hq = 0; hq < 4; ++hq) { mh[hq] = __shfl(mx, hq); sh[hq] = 0.f; }
    asm volatile("s_waitcnt lgkmcnt(0)" ::: "memory");
#pragma unroll
    for (int i = 0; i < 4; ++i) { LAS f32x4* pp = (LAS f32x4*)(pbuf + (lane + 64 * i) * 4); f32x4 v = *pp;
#pragma unroll
        for (int hq = 0; hq < 4; ++hq) { v[hq] = __builtin_amdgcn_exp2f(v[hq] - mh[hq]); sh[hq] += v[hq]; }
        *pp = v; }
#pragma unroll
    for (int hq = 0; hq < 4; ++hq) sh[hq] = 1.0f / wave_sum(sh[hq]);
    asm volatile("s_waitcnt lgkmcnt(0)" ::: "memory");
    const int ksub = lane >> 3, dc = lane & 7;
    float o[4][8];
#pragma unroll
    for (int hq = 0; hq < 4; ++hq)
#pragma unroll
        for (int e = 0; e < 8; ++e) o[hq][e] = 0.f;
#pragma unroll 1
    for (int ib = 0; ib < 32; ib += PVB) {
        bf16x8 vv[PVB];
#pragma unroll
        for (int j = 0; j < PVB; ++j) { const int key = (int)sel[8 * (ib + j) + ksub]; vv[j] = kv.v8(key, g, 8 * dc); }
#pragma unroll
        for (int j = 0; j < PVB; ++j) {
            const f32x4 pp = *(const LAS f32x4*)(pbuf + (8 * (ib + j) + ksub) * 4);
#pragma unroll
            for (int e = 0; e < 8; ++e) { const float vf = bf2f((u16)vv[j][e]);
#pragma unroll
                for (int hq = 0; hq < 4; ++hq) o[hq][e] = fmaf(pp[hq], vf, o[hq][e]); }
        }
    }
#pragma unroll
    for (int hq = 0; hq < 4; ++hq)
#pragma unroll
        for (int e = 0; e < 8; ++e) { float x = o[hq][e]; x += __shfl_xor(x, 8); x += __shfl_xor(x, 16); x += __shfl_xor(x, 32); o[hq][e] = x * sh[hq]; }
    if (ksub == 0) {
#pragma unroll
        for (int hq = 0; hq < 4; ++hq) { u32x4 w; w.x = pk2bf(o[hq][0], o[hq][1]); w.y = pk2bf(o[hq][2], o[hq][3]); w.z = pk2bf(o[hq][4], o[hq][5]); w.w = pk2bf(o[hq][6], o[hq][7]);
            *(u32x4*)(orow + (4 * g + hq) * 64 + 8 * dc) = w; }
    }
    asm volatile("s_waitcnt lgkmcnt(0)" ::: "memory");
}

template <class KV>
__device__ __forceinline__ void sparse_attn_part(const u16* zq, const KV& kv, const LAS unsigned* sel, int slot0, LAS float* pbuf, LAS float* part, int lane, int g) {
    const int col = lane & 15, kq = lane >> 4;
    bf16x8 bq0 = {}, bq1 = {};
    if (col < 4) { const u16* qp = zq + QA_OFF + (4 * g + col) * 64 + 8 * kq; bq0 = *(const bf16x8*)qp; bq1 = *(const bf16x8*)(qp + 32); }
    bf16x8 ka[4][2];
#pragma unroll
    for (int j = 0; j < 4; ++j) { const int key = (int)sel[slot0 + 16 * j + col]; ka[j][0] = kv.k8(key, g, 8 * kq); ka[j][1] = kv.k8(key, g, 32 + 8 * kq); }
    const int ksub = lane >> 3, dc = lane & 7;
    bf16x8 vv[8];
#pragma unroll
    for (int j = 0; j < 8; ++j) { const int key = (int)sel[slot0 + 8 * j + ksub]; vv[j] = kv.v8(key, g, 8 * dc); }
    float mx = -INFINITY;
    f32x4 lg[4];
#pragma unroll
    for (int j = 0; j < 4; ++j) {
        f32x4 acc = {};
        acc = __builtin_amdgcn_mfma_f32_16x16x32_bf16(ka[j][0], bq0, acc, 0, 0, 0);
        acc = __builtin_amdgcn_mfma_f32_16x16x32_bf16(ka[j][1], bq1, acc, 0, 0, 0);
#pragma unroll
        for (int e = 0; e < 4; ++e) { acc[e] *= (0.125f * LOG2E); mx = fmaxf(mx, acc[e]); }
        lg[j] = acc;
    }
    mx = fmaxf(mx, __shfl_xor(mx, 16)); mx = fmaxf(mx, __shfl_xor(mx, 32));
    float sm = 0.f;
#pragma unroll
    for (int j = 0; j < 4; ++j)
#pragma unroll
        for (int e = 0; e < 4; ++e) { const float pv = __builtin_amdgcn_exp2f(lg[j][e] - mx); sm += pv; if (col < 4) pbuf[(16 * j + 4 * kq + e) * 4 + col] = pv; }
    sm += __shfl_xor(sm, 16); sm += __shfl_xor(sm, 32);
    if (lane < 4) { part[lane] = mx; part[4 + lane] = sm; }
    asm volatile("s_waitcnt lgkmcnt(0)" ::: "memory");
    float o[4][8];
#pragma unroll
    for (int hq = 0; hq < 4; ++hq)
#pragma unroll
        for (int e = 0; e < 8; ++e) o[hq][e] = 0.f;
#pragma unroll
    for (int j = 0; j < 8; ++j) {
        const f32x4 pp = *(const LAS f32x4*)(pbuf + (8 * j + ksub) * 4);
#pragma unroll
        for (int e = 0; e < 8; ++e) { const float vf = bf2f((u16)vv[j][e]);
#pragma unroll
            for (int hq = 0; hq < 4; ++hq) o[hq][e] = fmaf(pp[hq], vf, o[hq][e]); }
    }
#pragma unroll
    for (int hq = 0; hq < 4; ++hq)
#pragma unroll
        for (int e = 0; e < 8; ++e) { float x = o[hq][e]; x += __shfl_xor(x, 8); x += __shfl_xor(x, 16); x += __shfl_xor(x, 32); o[hq][e] = x; }
    if (ksub == 0) {
#pragma unroll
        for (int hq = 0; hq < 4; ++hq) { *(LAS f32x4*)(part + 8 + hq * 64 + 8 * dc) = (f32x4){o[hq][0], o[hq][1], o[hq][2], o[hq][3]}; *(LAS f32x4*)(part + 8 + hq * 64 + 8 * dc + 4) = (f32x4){o[hq][4], o[hq][5], o[hq][6], o[hq][7]}; }
    }
}
__device__ __forceinline__ void attn_combine(const LAS float* part0, u16* orow, int lane, int g) {
#pragma unroll
    for (int hq = 0; hq < 4; ++hq) {
        float m = -INFINITY;
#pragma unroll
        for (int q = 0; q < 4; ++q) m = fmaxf(m, part0[q * 264 + hq]);
        float l = 0.f, ov = 0.f;
#pragma unroll
        for (int q = 0; q < 4; ++q) { const float sc = __builtin_amdgcn_exp2f(part0[q * 264 + hq] - m); l += part0[q * 264 + 4 + hq] * sc; ov += part0[q * 264 + 8 + hq * 64 + lane] * sc; }
        orow[(4 * g + hq) * 64 + lane] = (u16)f2bf(ov / l);
    }
}

__device__ __forceinline__ bf16x8 tr_pair(const LAS unsigned char* plo, const LAS unsigned char* phi) {
    typedef short v4i16_t __attribute__((ext_vector_type(4)));
    const v4i16_t lo = __builtin_amdgcn_ds_read_tr16_b64_v4i16((LAS v4i16_t*)plo), hi = __builtin_amdgcn_ds_read_tr16_b64_v4i16((LAS v4i16_t*)phi);
    return (bf16x8){lo[0], lo[1], lo[2], lo[3], hi[0], hi[1], hi[2], hi[3]};
}
constexpr int VST_ROW = 160, VST_BYTES = 64 * VST_ROW;
__device__ __forceinline__ void attn_wave(const u16* Z, const unsigned char* K8, const unsigned char* V8, size_t rowb, int q0w  , const LAS unsigned char* selw  , int wave,
                                          const LAS unsigned* ST, LAS unsigned char* vst, u16* ACAT, int lane) {
    const int col = lane & 15, kq = lane >> 4, li = lane & 15;
    const LAS unsigned char* trb = vst + (4 * kq + (li >> 2)) * VST_ROW + (li & 3) * 8;
    LAS unsigned char* wrb = vst + (lane >> 3) * VST_ROW + (lane & 7) * 16;
    u32x4 ka[16], vr[8], qr[2];
#define AT_SEL(QG) ((const LAS unsigned*)(selw + ((QG) >> 1) * 1024))
#define AT_ISSUE_K(QG, J0) do { const LAS unsigned* sl_ = AT_SEL(QG); const unsigned char* kb_ = K8 + rowb * 128 + ((QG) & 1) * 64 + 16 * kq; \
        _Pragma("unroll") for (int j = (J0); j < (J0) + 8; ++j) { const int key = (int)sl_[16 * j + col]; ka[j] = *(const u32x4*)(kb_ + (size_t)key * 128); } } while (0)
#define AT_ISSUE_V(QG, C) do { const LAS unsigned* sl_ = AT_SEL(QG); const u16* vb_ = Z + rowb * ZW + VA_OFF + ((QG) & 1) * 64 + 8 * (lane & 7); \
        _Pragma("unroll") for (int i = 0; i < 8; ++i) { const int key = (int)sl_[64 * (C) + 8 * i + (lane >> 3)]; vr[i] = *(const u32x4*)(vb_ + (size_t)key * ZW); } } while (0)
    AT_ISSUE_K(0, 0); AT_ISSUE_V(0, 0);
#pragma unroll 1
    for (int qg = 0; qg < 8; ++qg) {
        const int qq = qg >> 1, g = qg & 1;
        const int count = (int)ST[(wave * 4 + qq) * 4 + 2];
        AT_ISSUE_K(qg, 8);
        { const u16* qp_ = Z + (rowb + q0w + qq) * ZW + QA_OFF + (4 * g + (col & 3)) * 64 + 16 * kq; qr[0] = *(const u32x4*)qp_; qr[1] = *(const u32x4*)(qp_ + 8); }
        long bq0 = 0, bq1 = 0;
        if (col < 4) {
            const u32x2 a = pk8fp8((f32x4){bflo(qr[0].x), bfhi(qr[0].x), bflo(qr[0].y), bfhi(qr[0].y)}, (f32x4){bflo(qr[0].z), bfhi(qr[0].z), bflo(qr[0].w), bfhi(qr[0].w)});
            const u32x2 b = pk8fp8((f32x4){bflo(qr[1].x), bfhi(qr[1].x), bflo(qr[1].y), bfhi(qr[1].y)}, (f32x4){bflo(qr[1].z), bfhi(qr[1].z), bflo(qr[1].w), bfhi(qr[1].w)});
            bq0 = (long)(((unsigned long long)a.y << 32) | a.x); bq1 = (long)(((unsigned long long)b.y << 32) | b.x);
        }
        f32x4 lg[16];
#pragma unroll
        for (int j = 0; j < 16; ++j) {
            const long a0 = (long)(((unsigned long long)ka[j].y << 32) | ka[j].x), a1 = (long)(((unsigned long long)ka[j].w << 32) | ka[j].z);
            f32x4 acc = {}; acc = __builtin_amdgcn_mfma_f32_16x16x32_fp8_fp8(a0, bq0, acc, 0, 0, 0); lg[j] = __builtin_amdgcn_mfma_f32_16x16x32_fp8_fp8(a1, bq1, acc, 0, 0, 0);
        }
        if (count < TOPK) {
#pragma unroll
            for (int jg = 0; jg < 16; ++jg)
#pragma unroll
                for (int e = 0; e < 4; ++e) { const int slot = 16 * jg + 4 * kq + e; if (slot >= count) lg[jg][e] = -INFINITY; }
        }
        float mx = -INFINITY;
#pragma unroll
        for (int jg = 0; jg < 16; ++jg)
#pragma unroll
            for (int e = 0; e < 4; ++e) mx = fmaxf(mx, lg[jg][e]);
        mx = fmaxf(mx, __shfl_xor(mx, 16)); mx = fmaxf(mx, __shfl_xor(mx, 32));
        const float nmc = -mx * (0.125f * LOG2E);
        float sm = 0.f;
        unsigned pk[16][2];
#pragma unroll
        for (int jg = 0; jg < 16; ++jg) {
            float pv[4];
#pragma unroll
            for (int e = 0; e < 4; ++e) { pv[e] = __builtin_amdgcn_exp2f(fmaf(lg[jg][e], 0.125f * LOG2E, nmc)); sm += pv[e]; }
            pk[jg][0] = pk2bf(pv[0], pv[1]); pk[jg][1] = pk2bf(pv[2], pv[3]);
        }
        sm += __shfl_xor(sm, 16); sm += __shfl_xor(sm, 32);
        const float inv = 1.0f / sm;
        __builtin_amdgcn_sched_barrier(0);
        if (qg < 7) AT_ISSUE_K(qg + 1, 0);
        __builtin_amdgcn_sched_barrier(0);
        f32x4 oacc[4];
#pragma unroll
        for (int dg = 0; dg < 4; ++dg) oacc[dg] = (f32x4){0.f, 0.f, 0.f, 0.f};
#pragma unroll
        for (int c = 0; c < 4; ++c) {
#pragma unroll
            for (int i = 0; i < 8; ++i) *(LAS u32x4*)(wrb + 8 * i * VST_ROW) = vr[i];
            __builtin_amdgcn_sched_barrier(0);
            if (c < 3) AT_ISSUE_V(qg, c + 1); else if (qg < 7) AT_ISSUE_V(qg + 1, 0);
            asm volatile("s_waitcnt lgkmcnt(0)" ::: "memory");
            __builtin_amdgcn_sched_barrier(0);
#pragma unroll
            for (int s = 0; s < 2; ++s) {
                if (s) __builtin_amdgcn_sched_barrier(0);
                const int jg = 4 * c + 2 * s;
                const u32x4 bw = (u32x4){pk[jg][0], pk[jg][1], pk[jg + 1][0], pk[jg + 1][1]};
                const bf16x8 bfrag = __builtin_bit_cast(bf16x8, bw);
#pragma unroll
                for (int dg = 0; dg < 4; ++dg) {
                    const bf16x8 afrag = tr_pair(trb + (32 * s) * VST_ROW + dg * 32, trb + (32 * s + 16) * VST_ROW + dg * 32);
                    oacc[dg] = __builtin_amdgcn_mfma_f32_16x16x32_bf16(afrag, bfrag, oacc[dg], 0, 0, 0);
                }
            }
            asm volatile("s_waitcnt lgkmcnt(0)" ::: "memory");
        }
        if (col < 4) {
            u16* orow = ACAT + (rowb + q0w + qq) * 1536;
#pragma unroll
            for (int dg = 0; dg < 4; ++dg) { u32x2 w; w.x = pk2bf(oacc[dg][0] * inv, oacc[dg][1] * inv); w.y = pk2bf(oacc[dg][2] * inv, oacc[dg][3] * inv);
                *(u32x2*)(orow + (4 * g + col) * 64 + 16 * dg + 4 * kq) = w; }
        }
    }
#undef AT_SEL
#undef AT_ISSUE_K
#undef AT_ISSUE_V
}

constexpr int HROW = 513;
constexpr int MROW = 258;
constexpr int DL_QI = 0, DL_QIH = 32 * 144  , DL_W = 9 * DL_QIH  , DL_ST = DL_W + 1024, DL_HIST = DL_ST + 512  , DL_HBYTES = 32 * HROW * 4  ,
              DL_PB = DL_HIST + DL_HBYTES, DL_END = DL_PB + 8 * 4096;
constexpr int DL_MASK = DL_HIST, DL_CCNT = DL_HIST + 16640, DL_CL = DL_HIST + 16896, DL_SELL = DL_HIST + 32768;
constexpr int DL_WV = DL_HIST;
constexpr int CAND_CAP = 32;
static_assert(3 * 10240 <= DL_W && 2 * 10240 <= 32768 && 3 * 10240 <= 8 * 4096 && DL_END <= LDS_BYTES - 64 && 32 * MROW * 2 <= 16640 && DL_CL + 32 * CAND_CAP * 8 <= DL_SELL && DL_SELL + 32768 <= DL_PB && DL_HIST % 16 == 0, "DSA LDS map");

#define FMA_ABS(I, ACC, W) do { float s_ = sc[I]; s_ = fmaf(__builtin_fabsf((ACC)[I]), (W), s_); asm volatile("" : "+v"(s_)); sc[I] = s_; } while (0)
#define ST_MFMA(ACC, SLOT) do { if (PM == 2) { _Pragma("unroll") for (int i_ = 0; i_ < 16; ++i_) ACC[i_] = (float)ta[SLOT][i_ & 3][i_ & 7]; } else { ACC = (f32x16){0.f,0.f,0.f,0.f,0.f,0.f,0.f,0.f,0.f,0.f,0.f,0.f,0.f,0.f,0.f,0.f}; _Pragma("unroll") for (int ks = 0; ks < 4; ++ks) ACC = __builtin_amdgcn_mfma_f32_32x32x16_f16(kf[ks], ta[SLOT][ks], ACC, 0, 0, 0); } } while (0)
#define ST_LOAD(SLOT, HEAD) do { _Pragma("unroll") for (int ks = 0; ks < 4; ++ks) ta[SLOT][ks] = *(const LAS half8*)(qb + (HEAD) * DL_QIH + 32 * ks); } while (0)
#define ST_FMAS(ACC, W) do { if (PM == 1) { sc[0] += ACC[0] + ACC[5] + ACC[10] + ACC[15]; } else { _Pragma("unroll") for (int i = 0; i < 16; ++i) FMA_ABS(i, ACC, W); } } while (0)
#define ST_SCHED(NLD) do { _Pragma("unroll") for (int g_ = 0; g_ < 4; ++g_) { __builtin_amdgcn_sched_group_barrier(0x008, 1, 0); if (NLD) __builtin_amdgcn_sched_group_barrier(0x100, 1, 0); __builtin_amdgcn_sched_group_barrier(0x002, 4, 0); } } while (0)
template <int PM> __device__ __forceinline__ void score_tile(LAS unsigned char* lds, const half8 (&kf)[4], const float (&wq)[8], int r, int hh, f32x16& sc) {
    int qoff = r * 144 + 16 * hh; asm volatile("" : "+v"(qoff));
    const LAS unsigned char* qb = lds + DL_QI + qoff;
    half8 ta[3][4];
    f32x16 accA, accB;
    ST_LOAD(0, 8); ST_LOAD(1, 0); ST_LOAD(2, 1);
    __builtin_amdgcn_sched_barrier(0);
    ST_MFMA(accA, 0); ST_LOAD(0, 2);
    __builtin_amdgcn_sched_barrier(0);
    ST_MFMA(accB, 1); ST_LOAD(1, 3); sc = accA;
    __builtin_amdgcn_sched_barrier(0);
    ST_MFMA(accA, 2); ST_LOAD(2, 4); ST_FMAS(accB, wq[0]); ST_SCHED(1);
    __builtin_amdgcn_sched_barrier(0);
    ST_MFMA(accB, 0); ST_LOAD(0, 5); ST_FMAS(accA, wq[1]); ST_SCHED(1);
    __builtin_amdgcn_sched_barrier(0);
    ST_MFMA(accA, 1); ST_LOAD(1, 6); ST_FMAS(accB, wq[2]); ST_SCHED(1);
    __builtin_amdgcn_sched_barrier(0);
    ST_MFMA(accB, 2); ST_LOAD(2, 7); ST_FMAS(accA, wq[3]); ST_SCHED(1);
    __builtin_amdgcn_sched_barrier(0);
    ST_MFMA(accA, 0); ST_FMAS(accB, wq[4]); ST_SCHED(0);
    __builtin_amdgcn_sched_barrier(0);
    ST_MFMA(accB, 1); ST_FMAS(accA, wq[5]); ST_SCHED(0);
    __builtin_amdgcn_sched_barrier(0);
    ST_MFMA(accA, 2); ST_FMAS(accB, wq[6]); ST_SCHED(0);
    __builtin_amdgcn_sched_barrier(0);
    ST_FMAS(accA, wq[7]);
}
__device__ __forceinline__ unsigned key16(unsigned h) { return (h ^ ((h & 0x8000u) ? 0xffffu : 0x8000u)) & 0xffffu; }
constexpr int HROW8 = 129;
template <int PASS, bool DIAG>
__device__ __forceinline__ void dsa_tile_epi(LAS unsigned char* lds, const unsigned (&hw)[8], LAS unsigned char* hb, unsigned st, int klim, int kt, int r, int hh) {
    unsigned m16 = 0u, c16 = 0u;
#pragma unroll
    for (int rgi = 0; rgi < 16; ++rgi) {
        const int rg = 15 - rgi;
        const int kr = (rg & 3) + 8 * (rg >> 2);
        const unsigned k = key16((rg & 1) ? hw[rg >> 1] >> 16 : hw[rg >> 1] & 0xffffu);
        if (PASS == 0) { unsigned val = 1u << ((k >> 4) & 16u); if (DIAG) val = kr <= klim ? val : 0u; atomicAdd((unsigned*)(hb + ((k >> 7) & 0x1fcu)), val); }
        else if (PASS == 1) { unsigned val = (k >> 8) == st ? 1u << ((k << 4) & 16u) : 0u; if (DIAG) val = kr <= klim ? val : 0u; atomicAdd((unsigned*)(hb + ((k << 1) & 0x1fcu)), val); }
        else { bool gt = k > st, eq = k == st; if (DIAG) { gt = gt && kr <= klim; eq = eq && kr <= klim; }
            m16 = (m16 << 1) | (gt ? 1u : 0u); c16 = (c16 << 1) | (eq ? 1u : 0u); }
    }
    if (PASS == 2) {
        ((LAS u16*)(lds + DL_MASK))[r * MROW + kt * 2 + hh] = (u16)m16;
        if (__builtin_expect(__ballot(c16 != 0u) != 0ull, 0)) {
#pragma unroll
            for (int rg = 0; rg < 16; ++rg) if ((c16 >> rg) & 1u) { const unsigned pp = atomicAdd((unsigned*)((LAS unsigned*)(lds + DL_CCNT) + r), 1u);
                if (pp < (unsigned)CAND_CAP) ((LAS unsigned*)(lds + DL_CL))[r * CAND_CAP + pp] = (unsigned)(kt * 32 + (rg & 3) + 8 * (rg >> 2) + 4 * hh); }
        }
    }
}
template <bool HIST>
__device__ __forceinline__ void dsa_pass_a(LAS unsigned char* lds, const u16* Z, size_t rowb, int q0, int qt, int wave, int lane, unsigned char* scr) {
    const int r = lane & 31, hh = lane >> 5;
    if (wave > qt) return;
    float wq[8];
#pragma unroll
    for (int hd = 0; hd < 8; ++hd) wq[hd] = ((const LAS float*)(lds + DL_W))[hd * 32 + r];
    LAS unsigned char* hb = lds + DL_HIST + r * (HROW8 * 4);
    half8 kf[4];
    { const u16* kp = Z + (rowb + wave * 32 + r) * ZW + KI_OFF + 8 * hh;
#pragma unroll
      for (int ks = 0; ks < 4; ++ks) kf[ks] = *(const half8*)(kp + 16 * ks); }
#pragma unroll 1
    for (int kt = wave; kt <= qt; kt += 8) {
        f32x16 sc; score_tile<0>(lds, kf, wq, r, hh, sc);
        { const int ktn = kt + 8 <= qt ? kt + 8 : kt; const u16* kp = Z + (rowb + ktn * 32 + r) * ZW + KI_OFF + 8 * hh;
#pragma unroll
          for (int ks = 0; ks < 4; ++ks) kf[ks] = *(const half8*)(kp + 16 * ks); }
        unsigned hw[8];
#pragma unroll
        for (int i = 0; i < 8; ++i) hw[i] = pk2h(sc[2 * i], sc[2 * i + 1]);
        u32x4* sp = (u32x4*)(scr + ((size_t)kt * 64 + lane) * 32);
        sp[0] = (u32x4){hw[0], hw[1], hw[2], hw[3]}; sp[1] = (u32x4){hw[4], hw[5], hw[6], hw[7]};
        if (HIST) {
            const int klim = q0 + r - kt * 32 - 4 * hh;
            if (kt == qt) dsa_tile_epi<0, true>(lds, hw, hb, 0u, klim, kt, r, hh);
            else dsa_tile_epi<0, false>(lds, hw, hb, 0u, klim, kt, r, hh);
        }
    }
    asm volatile("s_waitcnt vmcnt(0)" ::: "memory");
}
template <int PASS>
__device__ __forceinline__ void dsa_pass_bc(LAS unsigned char* lds, int q0, int qt, int wave, int lane, const unsigned char* scr) {
    const int r = lane & 31, hh = lane >> 5;
    if (wave > qt) return;
    const unsigned st = ((const LAS unsigned*)(lds + DL_ST))[r * 4 + (PASS == 1 ? 0 : 1)];
    LAS unsigned char* hb = lds + DL_HIST + r * (HROW8 * 4);
    u32x4 cur0, cur1;
    { const u32x4* sp = (const u32x4*)(scr + ((size_t)wave * 64 + lane) * 32); cur0 = __builtin_nontemporal_load(sp); cur1 = __builtin_nontemporal_load(sp + 1); }
#pragma unroll 1
    for (int kt = wave; kt <= qt; kt += 8) {
        const unsigned hw[8] = {cur0.x, cur0.y, cur0.z, cur0.w, cur1.x, cur1.y, cur1.z, cur1.w};
        { const int ktn = kt + 8 <= qt ? kt + 8 : kt; const u32x4* sp = (const u32x4*)(scr + ((size_t)ktn * 64 + lane) * 32); cur0 = __builtin_nontemporal_load(sp); cur1 = __builtin_nontemporal_load(sp + 1); }
        const int klim = q0 + r - kt * 32 - 4 * hh;
        if (kt == qt) dsa_tile_epi<PASS, true>(lds, hw, hb, st, klim, kt, r, hh);
        else dsa_tile_epi<PASS, false>(lds, hw, hb, st, klim, kt, r, hh);
    }
}
__device__ __forceinline__ void hist_find8(const LAS unsigned* hw, int r, int lane, unsigned& bin, unsigned& above_out) {
    unsigned cnt[4], tot = 0u;
#pragma unroll
    for (int i = 0; i < 2; ++i) { const unsigned w = hw[2 * lane + i]; cnt[2 * i] = w & 0xffffu; cnt[2 * i + 1] = w >> 16; tot += cnt[2 * i] + cnt[2 * i + 1]; }
    unsigned suf = tot;
#pragma unroll
    for (int o = 1; o < 64; o <<= 1) { const unsigned t = __shfl_down(suf, o); if (lane + o < 64) suf += t; }
    const unsigned above = suf - tot;
    const bool mine = (above < (unsigned)r) && ((unsigned)r <= above + tot);
    unsigned d = 0u, cb = 0u, cumv = above; bool found = false;
#pragma unroll
    for (int j = 3; j >= 0; --j) { if (!found && cumv + cnt[j] >= (unsigned)r) { d = (unsigned)(4 * lane + j); cb = cumv; found = true; } cumv += cnt[j]; }
    const unsigned long long bm = __ballot(mine);
    const int src = __ffsll((long long)bm) - 1;
    bin = (unsigned)__shfl((int)d, src); above_out = (unsigned)__shfl((int)cb, src);
}

__device__ __forceinline__ void dsa_prompt_unit(const PA p, LAS unsigned char* lds, int b, int qt) {
    const int tid = fresh_tid(p.wv), lane = tid & 63, wave = __builtin_amdgcn_readfirstlane(tid >> 6);
    unsigned char* ws = p.ws();
    const u16* Z = (const u16*)(ws + WS_Z); const float* WI = (const float*)(ws + WS_WI);
    u16* ACAT = (u16*)(ws + WS_ACAT);
    const size_t rowb = (size_t)b * SEQ; const int q0 = qt * 32;
    LAS unsigned* ST = (LAS unsigned*)(lds + DL_ST);
    __syncthreads();
    for (int pc = tid; pc < 2048; pc += 512) { const int row = pc >> 6, c = pc & 63, hd = c >> 3, d8 = c & 7;
        const u32x4 v = *(const u32x4*)(Z + (rowb + q0 + row) * ZW + QI_OFF + c * 8);
        *(LAS u32x4*)(lds + DL_QI + hd * DL_QIH + row * 144 + d8 * 16) = v; }
    if (tid < 256) {
        const int row = tid >> 3, d8 = tid & 7;
        const float* wr = WI + (rowb + q0 + row) * 8; const f32x4 wa = *(const f32x4*)wr, wb = *(const f32x4*)(wr + 4);
        const float wh[8] = {wa[0], wa[1], wa[2], wa[3], wb[0], wb[1], wb[2], wb[3]};
        float accq[8];
#pragma unroll
        for (int e = 0; e < 8; ++e) accq[e] = 0.f;
#pragma unroll
        for (int hd = 0; hd < 8; ++hd) {
            const half8 qv = *(const half8*)(Z + (rowb + q0 + row) * ZW + QI_OFF + hd * 64 + d8 * 8); const float wv = wh[hd] * (0.5f * IDX_C);
#pragma unroll
            for (int e = 0; e < 8; ++e) accq[e] = fmaf((float)qv[e], wv, accq[e]);
            if (hd == d8) ((LAS float*)(lds + DL_W))[hd * 32 + row] = wv;
        }
        half8 o;
#pragma unroll
        for (int e = 0; e < 8; ++e) o[e] = (_Float16)accq[e];
        *(LAS half8*)(lds + DL_QI + 8 * DL_QIH + row * 144 + d8 * 16) = o;
    }
    unsigned zz = 0u; asm volatile("" : "+v"(zz));
    if (tid < 32) { ST[tid * 4] = ~zz; ST[tid * 4 + 1] = zz; ST[tid * 4 + 2] = zz; ST[tid * 4 + 3] = zz; }
    const bool need_sel = q0 + 32 > TOPK;
    unsigned char* scr = ws + WS_SSC + (size_t)blockIdx.x * (32 * 4096 * 4);
    if (need_sel) { for (int i = tid; i < 32 * HROW8 * 4 / 16; i += 512) *(LAS u32x4*)(lds + DL_HIST + i * 16) = (u32x4){zz, zz, zz, zz}; }
    __syncthreads();
    if (need_sel) {
        dsa_pass_a<true>(lds, Z, rowb, q0, qt, wave, lane, scr);
        __syncthreads();
#pragma unroll 1
        for (int qq = 0; qq < 4; ++qq) { const int ql = wave * 4 + qq; unsigned bin, above; hist_find8((const LAS unsigned*)(lds + DL_HIST) + ql * HROW8, TOPK, lane, bin, above);
            if (lane == 0) { ST[ql * 4] = bin; ST[ql * 4 + 2] = (unsigned)TOPK - above; } }
        __syncthreads();
        for (int i = tid; i < 32 * HROW8 * 4 / 16; i += 512) *(LAS u32x4*)(lds + DL_HIST + i * 16) = (u32x4){zz, zz, zz, zz};
        __syncthreads();
        dsa_pass_bc<1>(lds, q0, qt, wave, lane, scr);
        __syncthreads();
#pragma unroll 1
        for (int qq = 0; qq < 4; ++qq) { const int ql = wave * 4 + qq; const unsigned r1 = ST[ql * 4 + 2]; unsigned bin, above; hist_find8((const LAS unsigned*)(lds + DL_HIST) + ql * HROW8, (int)r1, lane, bin, above);
            if (lane == 0) { ST[ql * 4 + 1] = (ST[ql * 4] << 8) | bin; ST[ql * 4 + 3] = r1 - above; } }
        __syncthreads();
    } else {
        dsa_pass_a<false>(lds, Z, rowb, q0, qt, wave, lane, scr);
    }
    for (int i = tid; i < 16896 / 16; i += 512) *(LAS u32x4*)(lds + DL_MASK + i * 16) = (u32x4){zz, zz, zz, zz};
    __syncthreads();
    dsa_pass_bc<2>(lds, q0, qt, wave, lane, scr);
    __syncthreads();
#pragma unroll 1
    for (int qq = 0; qq < 4; ++qq) {
        const int ql = wave * 4 + qq;
        LAS unsigned* sel = (LAS unsigned*)(lds + DL_SELL + wave * 4096 + qq * 1024);
        const LAS u16* mrow = (const LAS u16*)(lds + DL_MASK) + ql * MROW + 4 * lane;
        unsigned w0 = (unsigned)mrow[0] | ((unsigned)mrow[1] << 16), w1 = (unsigned)mrow[2] | ((unsigned)mrow[3] << 16);
        const int c = __popc(w0) + __popc(w1);
        int inc = c;
#pragma unroll
        for (int o = 1; o < 64; o <<= 1) { const int t = __shfl_up(inc, o); if (lane >= o) inc += t; }
        const int total = __shfl(inc, 63);
        int pos = inc - c;
        while (w0) { const int bb = __ffs((int)w0) - 1, rg = bb & 15; if (pos < TOPK) sel[pos] = (unsigned)(64 * lane + (rg & 3) + 8 * (rg >> 2) + 4 * (bb >> 4)); ++pos; w0 &= w0 - 1u; }
        while (w1) { const int bb = __ffs((int)w1) - 1, rg = bb & 15; if (pos < TOPK) sel[pos] = (unsigned)(64 * lane + 32 + (rg & 3) + 8 * (rg >> 2) + 4 * (bb >> 4)); ++pos; w1 &= w1 - 1u; }
        int cc = (int)((const LAS unsigned*)(lds + DL_CCNT))[ql]; cc = cc < CAND_CAP ? cc : CAND_CAP;
        const int r2 = (int)ST[ql * 4 + 3];
        int ntake = 0;
        if (r2 > 0 && cc > 0) {
            const unsigned xi = ((const LAS unsigned*)(lds + DL_CL))[ql * CAND_CAP + (lane < cc ? lane : 0)]; int rank = 0;
            for (int j = 0; j < cc; ++j) { const unsigned xj = (unsigned)__shfl((int)xi, j); rank += xj < xi ? 1 : 0; }
            if (lane < cc && rank < r2 && total + rank < TOPK) sel[total + rank] = xi;
            ntake = r2 < cc ? r2 : cc;
        }
        const int count = total + ntake;
        for (int i = count + lane; i < TOPK; i += 64) sel[i] = 0u;
        if (lane == 0) ST[ql * 4 + 2] = (unsigned)(count < TOPK ? count : TOPK);
    }
    asm volatile("s_waitcnt lgkmcnt(0)" ::: "memory");
    __syncthreads();
    LAS unsigned char* vst = wave < 3 ? lds + DL_QI + wave * VST_BYTES : (wave < 5 ? lds + DL_HIST + (wave - 3) * VST_BYTES : lds + DL_PB + (wave - 5) * VST_BYTES);
    REP(9) attn_wave(Z, ws + WS_K8, ws + WS_V8, rowb, q0 + wave * 4, lds + DL_SELL + wave * 4096, wave, ST, vst, ACAT, lane);
}

constexpr int GB_QT = 0, GB_KD = 17408, GB_AT = GB_KD + 18432, GB_VT = GB_AT + 9216, GB_GT = GB_VT + 4608  , GB_BUF = GB_GT + 5120  , GB_ST = 2 * GB_BUF, GB_STB = 8704  , GB_DEC = GB_ST + 2 * GB_STB, GB_END = GB_DEC + 1024;
static_assert(GB_END <= LDS_BYTES, "GLA-B LDS map");
struct ChainRegs { u32x4 q[2], k[2], a, v; float d; };
__device__ __forceinline__ void chain_load(const PA p, ChainRegs& R, int cid, int h, int dvb, int tid) {
    unsigned char* ws = p.ws();
    const u16* Z = (const u16*)(ws + WS_Z); const u16* QT = (const u16*)(ws + WS_QT); const u16* KDT = (const u16*)(ws + WS_KDT); const u16* ATT = (const u16*)(ws + WS_ATT);
    const float* DEC = (const float*)(ws + WS_DEC);
    const int R0 = cid < 512 ? cid * 64 : MP + (cid - 512) * 8, nv = cid < 512 ? 64 : 8;
#pragma unroll
    for (int i = 0; i < 2; ++i) { const int pc = tid + 512 * i, row = pc >> 4, c16 = pc & 15;
        R.q[i] = row < nv ? *(const u32x4*)(QT + (size_t)(R0 + row) * 512 + h * 128 + c16 * 8) : (u32x4){0u, 0u, 0u, 0u};
        const int dk = pc >> 3, c8 = pc & 7;
        R.k[i] = *(const u32x4*)(KDT + (((size_t)cid * 4 + h) * 128 + dk) * 64 + c8 * 8); }
    R.a = *(const u32x4*)(ATT + ((size_t)cid * 4 + h) * 4096 + (tid >> 3) * 64 + (tid & 7) * 8);
    R.v = (u32x4){0u, 0u, 0u, 0u};
    { const int t = (tid & 255) >> 2, c4 = tid & 3;
      if (t < nv) R.v = *(const u32x4*)(Z + (size_t)(R0 + t) * ZW + (tid < 256 ? VB_OFF : GB_OFF) + h * 256 + dvb * 32 + c4 * 8); }
    R.d = tid < 128 ? DEC[((size_t)cid * 4 + h) * 128 + tid] : 0.f;
}
__device__ __forceinline__ void chain_store_lds(const ChainRegs& R, LAS unsigned char* buf, LAS float* dec, int tid) {
#pragma unroll
    for (int i = 0; i < 2; ++i) { const int pc = tid + 512 * i, row = pc >> 4, c16 = pc & 15;
        *(LAS u32x4*)(buf + GB_QT + row * 272 + c16 * 16) = R.q[i];
        const int dk = pc >> 3, c8 = pc & 7;
        *(LAS u32x4*)(buf + GB_KD + dk * 144 + c8 * 16) = R.k[i]; }
    *(LAS u32x4*)(buf + GB_AT + (tid >> 3) * 144 + (tid & 7) * 16) = R.a;
    if (tid < 256) { const int t = tid >> 2, c4 = tid & 3;
        const unsigned w[4] = {R.v.x, R.v.y, R.v.z, R.v.w};
#pragma unroll
        for (int e = 0; e < 8; ++e) *(LAS u16*)(buf + GB_VT + (8 * c4 + e) * 144 + t * 2) = (u16)((e & 1) ? (w[e >> 1] >> 16) : (w[e >> 1] & 0xffffu)); }
    else { const int t = (tid - 256) >> 2, c4 = tid & 3; *(LAS u32x4*)(buf + GB_GT + t * 80 + c4 * 16) = R.v; }
    if (tid < 128) dec[tid] = R.d;
}
__device__ __forceinline__ void gla_chain(const PA p, LAS unsigned char* lds, int cid0, int nchunks, int h, int dvb, const float* s0, float* sout) {
    const int tid = fresh_tid(p.wv), lane = tid & 63, wave = __builtin_amdgcn_readfirstlane(tid >> 6);
    const int r = lane & 31, hh = lane >> 5;
    u16* OB = (u16*)(p.ws() + WS_ACAT); float* SSQ = (float*)(p.ws() + WS_SS); float* PSQ = (float*)(p.ws() + WS_ORAW);
#define CH_DPP(X, CTRL) __builtin_bit_cast(float, __builtin_amdgcn_update_dpp(0, __builtin_bit_cast(int, (float)(X)), (CTRL), 0xf, 0xf, true))
    f32x16 S = {};
    if (wave < 4 && s0) {
#pragma unroll
        for (int rg = 0; rg < 16; ++rg) { const int dk = 32 * wave + (rg & 3) + 8 * (rg >> 2) + 4 * hh; S[rg] = s0[(size_t)dk * 256 + dvb * 32 + r]; }
    }
    __syncthreads();
    ChainRegs RA, RB;
    chain_load(p, RA, cid0, h, dvb, tid);
    chain_store_lds(RA, lds, (LAS float*)(lds + GB_DEC), tid);
    if (nchunks > 1) chain_load(p, RA, cid0 + 1, h, dvb, tid);
    if (wave < 4) {
#pragma unroll
        for (int g4 = 0; g4 < 4; ++g4) { u32x2 w; w.x = pk2bf(S[4 * g4], S[4 * g4 + 1]); w.y = pk2bf(S[4 * g4 + 2], S[4 * g4 + 3]);
            *(LAS u32x2*)(lds + GB_ST + r * 272 + (32 * wave + 8 * g4 + 4 * hh) * 2) = w; }
    }
    __syncthreads();
#define CHAIN_STEP(C, RX, RY) do { \
        const int c_ = (C); const int cid = cid0 + c_; \
        LAS unsigned char* buf = lds + (c_ & 1) * GB_BUF; LAS unsigned char* nbuf = lds + ((c_ + 1) & 1) * GB_BUF; \
        LAS float* dec = (LAS float*)(lds + GB_DEC + (c_ & 1) * 512); LAS float* ndec = (LAS float*)(lds + GB_DEC + ((c_ + 1) & 1) * 512); \
        const LAS unsigned char* stc = lds + GB_ST + (c_ & 1) * GB_STB; LAS unsigned char* stn = lds + GB_ST + ((c_ + 1) & 1) * GB_STB;        \
        if (c_ + 2 < nchunks) chain_load(p, RY, cid + 2, h, dvb, tid); \
        if (wave < 4) {        \
            _Pragma("unroll") for (int g4 = 0; g4 < 4; ++g4) { const f32x4 d4 = *(const LAS f32x4*)(dec + 32 * wave + 8 * g4 + 4 * hh); \
                _Pragma("unroll") for (int e = 0; e < 4; ++e) S[4 * g4 + e] *= d4[e]; } \
            _Pragma("unroll") for (int ks = 0; ks < 4; ++ks) { \
                const bf16x8 a = *(const LAS bf16x8*)(buf + GB_KD + (32 * wave + r) * 144 + (16 * ks + 8 * hh) * 2); \
                const bf16x8 bv = *(const LAS bf16x8*)(buf + GB_VT + r * 144 + (16 * ks + 8 * hh) * 2); \
                S = __builtin_amdgcn_mfma_f32_32x32x16_bf16(a, bv, S, 0, 0, 0); } \
            if (c_ + 1 < nchunks) { _Pragma("unroll") for (int g4 = 0; g4 < 4; ++g4) { u32x2 w; w.x = pk2bf(S[4 * g4], S[4 * g4 + 1]); w.y = pk2bf(S[4 * g4 + 2], S[4 * g4 + 3]); \
                *(LAS u32x2*)(stn + r * 272 + (32 * wave + 8 * g4 + 4 * hh) * 2) = w; } } \
        } else { \
              \
            const int w4 = wave - 4, tt = w4 & 1, dh = w4 >> 1, r16 = lane & 15, q4 = lane >> 4, nk32 = tt + 1; \
            f32x4 o0 = {0.f, 0.f, 0.f, 0.f}, o1 = {0.f, 0.f, 0.f, 0.f}; \
            for (int ks = 0; ks < nk32; ++ks) { \
                const bf16x8 bv = *(const LAS bf16x8*)(buf + GB_VT + (16 * dh + r16) * 144 + (32 * ks + 8 * q4) * 2); \
                const bf16x8 a0 = *(const LAS bf16x8*)(buf + GB_AT + (32 * tt + r16) * 144 + (32 * ks + 8 * q4) * 2); \
                const bf16x8 a1 = *(const LAS bf16x8*)(buf + GB_AT + (32 * tt + 16 + r16) * 144 + (32 * ks + 8 * q4) * 2); \
                o0 = __builtin_amdgcn_mfma_f32_16x16x32_bf16(bv, a0, o0, 0, 0, 0); o1 = __builtin_amdgcn_mfma_f32_16x16x32_bf16(bv, a1, o1, 0, 0, 0); } \
            _Pragma("unroll") for (int ks = 0; ks < 4; ++ks) { \
                const bf16x8 bs = *(const LAS bf16x8*)(stc + (16 * dh + r16) * 272 + (32 * ks + 8 * q4) * 2); \
                const bf16x8 a0 = *(const LAS bf16x8*)(buf + GB_QT + (32 * tt + r16) * 272 + (32 * ks + 8 * q4) * 2); \
                const bf16x8 a1 = *(const LAS bf16x8*)(buf + GB_QT + (32 * tt + 16 + r16) * 272 + (32 * ks + 8 * q4) * 2); \
                o0 = __builtin_amdgcn_mfma_f32_16x16x32_bf16(bs, a0, o0, 0, 0, 0); o1 = __builtin_amdgcn_mfma_f32_16x16x32_bf16(bs, a1, o1, 0, 0, 0); } \
            const int R0 = cid < 512 ? cid * 64 : MP + (cid - 512) * 8, nv = cid < 512 ? 64 : 8; \
              \
            const int t0 = 32 * tt + r16, t1 = t0 + 16; \
            const u32x2 gw0 = *(const LAS u32x2*)(buf + GB_GT + t0 * 80 + (16 * dh + 4 * q4) * 2), gw1 = *(const LAS u32x2*)(buf + GB_GT + t1 * 80 + (16 * dh + 4 * q4) * 2); \
            float q0 = o0[0] * o0[0] + o0[1] * o0[1] + o0[2] * o0[2] + o0[3] * o0[3], q1 = o1[0] * o1[0] + o1[1] * o1[1] + o1[2] * o1[2] + o1[3] * o1[3]; \
            q0 += __shfl_xor(q0, 16); q0 += __shfl_xor(q0, 32); q1 += __shfl_xor(q1, 16); q1 += __shfl_xor(q1, 32);        \
            if (q4 == 0) {        \
                if (cid < 512) { PSQ[((size_t)(R0 + t0) * 4 + h) * 16 + dvb * 2 + dh] = q0; PSQ[((size_t)(R0 + t1) * 4 + h) * 16 + dvb * 2 + dh] = q1; } \
                else { if (t0 < nv) atomicAdd(SSQ + (size_t)(R0 + t0) * 4 + h, q0); if (t1 < nv) atomicAdd(SSQ + (size_t)(R0 + t1) * 4 + h, q1); } } \
            { u32x2 w0, w1; \
              w0.x = pk2bf(o0[0] * bflo(gw0.x), o0[1] * bfhi(gw0.x)); w0.y = pk2bf(o0[2] * bflo(gw0.y), o0[3] * bfhi(gw0.y)); \
              w1.x = pk2bf(o1[0] * bflo(gw1.x), o1[1] * bfhi(gw1.x)); w1.y = pk2bf(o1[2] * bflo(gw1.y), o1[3] * bfhi(gw1.y)); \
              if (t0 < nv) *(u32x2*)(OB + (size_t)(R0 + t0) * 1536 + 512 + h * 256 + dvb * 32 + 16 * dh + 4 * q4) = w0; \
              if (t1 < nv) *(u32x2*)(OB + (size_t)(R0 + t1) * 1536 + 512 + h * 256 + dvb * 32 + 16 * dh + 4 * q4) = w1; } \
        } \
        if (c_ + 1 < nchunks) chain_store_lds(RX, nbuf, ndec, tid); \
        __syncthreads();        \
    } while (0)
#pragma unroll 1
    for (int c = 0; c < nchunks; c += 2) {
        CHAIN_STEP(c, RA, RB);
        if (c + 1 < nchunks) CHAIN_STEP(c + 1, RB, RA);
    }
#undef CHAIN_STEP
#undef CH_DPP
    if (wave < 4) {
#pragma unroll
        for (int rg = 0; rg < 16; ++rg) { const int dk = 32 * wave + (rg & 3) + 8 * (rg >> 2) + 4 * hh; sout[(size_t)dk * 256 + dvb * 32 + r] = S[rg]; }
    }
}

template <int NR>
__device__ __forceinline__ void onorm_rows(const PA p, int m0, int step, int lane) {
    unsigned char* ws = p.ws();
    const u16* Z = (const u16*)(ws + WS_Z); const u16* ORAW = (const u16*)(ws + WS_ORAW); u16* ACAT = (u16*)(ws + WS_ACAT);
    const float* gn = p.in(10) + (lane & 15) * 16;
    float gnv[16];
#pragma unroll
    for (int i = 0; i < 16; ++i) gnv[i] = gn[i];
    for (int m = m0; m < MT; m += NR * step) {
        u32x4 ov[NR][2], gv[NR][2];
#pragma unroll
        for (int k = 0; k < NR; ++k) { const int row = m + k * step < MT ? m + k * step : m;
            ov[k][0] = *(const u32x4*)(ORAW + (size_t)row * DM + lane * 16); ov[k][1] = *(const u32x4*)(ORAW + (size_t)row * DM + lane * 16 + 8);
            gv[k][0] = *(const u32x4*)(Z + (size_t)row * ZW + GB_OFF + lane * 16); gv[k][1] = *(const u32x4*)(Z + (size_t)row * ZW + GB_OFF + lane * 16 + 8); }
#pragma unroll
        for (int k = 0; k < NR; ++k) {
            if (m + k * step >= MT) break;
            const int row = m + k * step;
            float o[16], gb[16];
            const unsigned ow[8] = {ov[k][0].x, ov[k][0].y, ov[k][0].z, ov[k][0].w, ov[k][1].x, ov[k][1].y, ov[k][1].z, ov[k][1].w};
            const unsigned gw[8] = {gv[k][0].x, gv[k][0].y, gv[k][0].z, gv[k][0].w, gv[k][1].x, gv[k][1].y, gv[k][1].z, gv[k][1].w};
            float ss = 0.f;
#pragma unroll
            for (int i = 0; i < 8; ++i) { o[2 * i] = bflo(ow[i]); o[2 * i + 1] = bfhi(ow[i]); gb[2 * i] = bflo(gw[i]); gb[2 * i + 1] = bfhi(gw[i]); ss += o[2 * i] * o[2 * i] + o[2 * i + 1] * o[2 * i + 1]; }
            ss += __shfl_xor(ss, 1); ss += __shfl_xor(ss, 2); ss += __shfl_xor(ss, 4); ss += __shfl_xor(ss, 8);
            const float rinv = 1.0f / sqrtf(ss * (1.0f / 256.0f) + NORM_EPS);
            unsigned w[8];
#pragma unroll
            for (int i = 0; i < 8; ++i) {
                const float a = o[2 * i] * rinv * gb[2 * i];
                const float bq = o[2 * i + 1] * rinv * gb[2 * i + 1];
                w[i] = pk2bf(a, bq);
            }
            u16* dst = ACAT + (size_t)row * 1536 + 512 + lane * 16;
            *(u32x4*)dst = (u32x4){w[0], w[1], w[2], w[3]}; *(u32x4*)(dst + 8) = (u32x4){w[4], w[5], w[6], w[7]};
        }
    }
}
__device__ __forceinline__ void ffn_colsums(const PA p, int gw, int ngw, int lane) {
    float* C1 = (float*)(p.ws() + WS_CTL + CTL_C1); float* C2 = (float*)(p.ws() + WS_CTL + CTL_C2);
    const float* W = p.in(16); const float* g1 = p.in(14); const float* b1 = p.in(15);
    for (int it = gw; it < 64 * 32; it += ngw) {
        const int cg = it & 63, ks = it >> 6, n = cg * 64 + lane;
        float s1 = 0.f, s2 = 0.f;
#pragma unroll 8
        for (int kk = 0; kk < 32; ++kk) { const int k = ks * 32 + kk; const float w = W[(size_t)k * DFF + n]; s1 = fmaf(g1[k], w, s1); s2 = fmaf(b1[k], w, s2); }
        atomicAdd(C1 + n, s1); atomicAdd(C2 + n, s2);
    }
}
template <int NR>
__device__ __forceinline__ void ln_rows(const float* src, float* dst, u16* dstb, const float* g, const float* bt, int m0, int step, int lane) {
    for (int m = m0; m < MT; m += NR * step) {
        f32x4 v[NR][4];
#pragma unroll
        for (int k = 0; k < NR; ++k) { const int mk = m + k * step < MT ? m + k * step : m; const f32x4* x4 = (const f32x4*)(src + (size_t)mk * DM) + lane;
#pragma unroll
            for (int j = 0; j < 4; ++j) v[k][j] = x4[64 * j]; }
#pragma unroll
        for (int k = 0; k < NR; ++k) {
            if (m + k * step >= MT) break;
            const size_t ro = (size_t)(m + k * step) * DM;
            float s = 0.f;
#pragma unroll
            for (int j = 0; j < 4; ++j) s += (v[k][j][0] + v[k][j][1]) + (v[k][j][2] + v[k][j][3]);
            const float mean = wave_sum(s) * (1.f / DM); float s2 = 0.f;
#pragma unroll
            for (int j = 0; j < 4; ++j) { v[k][j] = v[k][j] - mean; s2 += (v[k][j][0] * v[k][j][0] + v[k][j][1] * v[k][j][1]) + (v[k][j][2] * v[k][j][2] + v[k][j][3] * v[k][j][3]); }
            const float rstd = 1.f / sqrtf(wave_sum(s2) * (1.f / DM) + NORM_EPS);
#pragma unroll
            for (int j = 0; j < 4; ++j) {
                const f32x4 gg = *((const f32x4*)g + lane + 64 * j), bb = *((const f32x4*)bt + lane + 64 * j);
                const f32x4 y = v[k][j] * rstd * gg + bb;
                *((f32x4*)(dst + ro) + lane + 64 * j) = y;
                if (dstb) { u32x2 o; o.x = pk2bf(y[0], y[1]); o.y = pk2bf(y[2], y[3]); *((u32x2*)(dstb + ro) + lane + 64 * j) = o; }
            }
        }
    }
}

__device__ __forceinline__ void ln2_rows(const u16* VB, const float* STAT2, float* Y, const float* g, const float* bt, int m0, int step, int lane) {
    f32x4 gg[4], bb[4];
#pragma unroll
    for (int j = 0; j < 4; ++j) { gg[j] = *((const f32x4*)g + lane + 64 * j); bb[j] = *((const f32x4*)bt + lane + 64 * j); }
    for (int m = m0; m < MT; m += 4 * step) {
        u32x2 v[4][4]; f32x2_cv st[4];
#pragma unroll
        for (int k = 0; k < 4; ++k) { const int mk = m + k * step < MT ? m + k * step : m; st[k] = *(const f32x2_cv*)(STAT2 + (size_t)mk * 2);
#pragma unroll
            for (int j = 0; j < 4; ++j) v[k][j] = *((const u32x2*)(VB + (size_t)mk * DM) + lane + 64 * j); }
#pragma unroll
        for (int k = 0; k < 4; ++k) {
            if (m + k * step >= MT) break;
            const float mean = st[k][0] * (1.0f / DM), rstd = 1.0f / sqrtf(st[k][1] * (1.0f / DM) - mean * mean + NORM_EPS);
#pragma unroll
            for (int j = 0; j < 4; ++j) {
                const f32x4 x = (f32x4){bflo(v[k][j].x), bfhi(v[k][j].x), bflo(v[k][j].y), bfhi(v[k][j].y)};
                *((f32x4*)(Y + (size_t)(m + k * step) * DM) + lane + 64 * j) = (x - mean) * rstd * gg[j] + bb[j];
            }
        }
    }
}

__global__ void __launch_bounds__(512, 2) mk_fwd(Params p_unused) {
    extern __shared__ __attribute__((aligned(16))) unsigned char lds_raw[];
    LAS unsigned char* lds = (LAS unsigned char*)lds_raw;
    cg::grid_group grid = cg::this_grid();
    const PA p{(kaptr_t)__builtin_amdgcn_kernarg_segment_ptr(), __builtin_amdgcn_readfirstlane((int)threadIdx.x >> 6)};
    const int G = gridDim.x, B = blockIdx.x;
    volatile LAS unsigned* bst = (volatile LAS unsigned*)(lds + LDS_BYTES - 64);
    if (threadIdx.x < 2) bst[threadIdx.x] = 0u;
    __syncthreads();
    const XcdBarrier xbar = xcd_barrier_post((unsigned*)(p.ws() + WS_CTL) + 4096, bst);
    const int vcu = (G % 8 == 0) ? (B % 8) * (G / 8) + B / 8 : B;
    unsigned char* ws = p.ws();
    u16* Z = (u16*)(ws + WS_Z);

    REP(10) phase_prologue(p, lds);
    grid.sync();

    REP(1) { pg8::Gemm g{(const u16*)(ws + WS_XB), (const u16*)(ws + WS_WIN), MP, ZW, DM, DM, DM}; pg8::StaticOrder S; S.init(MP, ZW, G, B);
      EpiZ E{Z, p.out(), (float*)(ws + WS_WI), (float*)(ws + WS_AB), ws + WS_K8, ws + WS_V8, ZW};
      pg8::gemm_phase<EpiZ, true>(lds, g, S, E, p.wv);
      ElZ El{Z, p.out(), (float*)(ws + WS_WI), (float*)(ws + WS_AB)};
      REP(19) mini_gemm_slab(lds, (const u16*)(ws + WS_XB) + (size_t)MP * DM, DM, (const u16*)(ws + WS_WIN), DM, ZW, DM, El, B, G, p.wv); }
    xcd_barrier(xbar);

    REP(2) for (int u = vcu; u < NCHUNK; u += G) gla_a_chunk(p, lds, u);
    REP(3) { const int tid = fresh_tid(p.wv), lane = tid & 63, wave = __builtin_amdgcn_readfirstlane(tid >> 6);
      sample_scores_phase(p, lane);
      ffn_colsums(p, B * 8 + wave, G * 8, lane); }
    xcd_barrier(xbar);

    REP(4) for (int vb = B; vb < 256; vb += G) {
        const int b = vb & 7, j = vb >> 3;
#pragma unroll 1
        for (int s4 = 0; s4 < 4; ++s4) { const int qt = s4 == 0 ? j : (s4 == 1 ? 63 - j : (s4 == 2 ? 64 + j : 127 - j)); dsa_prompt_unit(p, lds, b, qt); }
    }
    __syncthreads();
    REP(5) for (int q = B; q < MS; q += G) {
        const int tid = fresh_tid(p.wv), lane = tid & 63, wave = __builtin_amdgcn_readfirstlane(tid >> 6);
        const int bs = q >> 3, t = q & 7;
        LAS unsigned* hist = (LAS unsigned*)(lds + DL_WV); LAS unsigned* sel = (LAS unsigned*)(lds + DL_WV + 8192); LAS unsigned* xch = (LAS unsigned*)(lds + DL_W);
        __syncthreads();
        int cnt = 0; REP(18) cnt = select_topk_block((const float*)(ws + WS_SSM) + (size_t)q * SSTR, PAST + t + 1, hist, sel, xch, tid);
        {
            KVSample kv{p.in(2), p.in(3), p.out() + OFF_KS + (size_t)bs * 8 * 128, p.out() + OFF_VS + (size_t)bs * 8 * 128, (const int*)p.in(6) + bs * NPAGES};
            if (tid < TOPK) sel[tid] = kv.code((int)sel[tid]);
            __syncthreads();
            LAS float* partb = (LAS float*)(lds + DL_WV + 32768);
            LAS float* pbuf = (LAS float*)(lds + DL_WV + 16384 + wave * 1024);
            sparse_attn_part<KVSample>(Z + (size_t)(MP + q) * ZW, kv, sel, 64 * (wave >> 1), pbuf, partb + ((wave & 1) * 4 + (wave >> 1)) * 264, lane, wave & 1);
            __syncthreads();
            if (wave < 2) attn_combine(partb + wave * 4 * 264, (u16*)(ws + WS_ACAT) + (size_t)(MP + q) * 1536, lane, wave);
        }
    }
    REP(6) for (int ci = vcu; ci < 256 + 1024; ci += G) {
        if (ci < 256) { const int b = ci >> 5, h = (ci >> 3) & 3, dvb = ci & 7;
            gla_chain(p, lds, b * 64, 64, h, dvb, nullptr, p.out() + OFF_GP + ((size_t)b * 4 + h) * 128 * 256); }
        else { const int c2 = ci - 256, bs = c2 >> 5, h = (c2 >> 3) & 3, dvb = c2 & 7;
            gla_chain(p, lds, 512 + bs, 1, h, dvb, p.in(5) + ((size_t)bs * 4 + h) * 128 * 256, p.out() + OFF_GS + ((size_t)bs * 4 + h) * 128 * 256); }
    }
    xcd_barrier(xbar);


    REP(11) {
    { pg8::Gemm g{(const u16*)(ws + WS_ACAT), (const u16*)(ws + WS_WAO), MP, DM, 1536, 1536, 1536}; pg8::StaticOrder S; S.init(MP, DM, G, B);
      EpiMerge E{Z, (u16*)(ws + WS_MRG), (const float*)(ws + WS_ORAW)};
      pg8::gemm_phase<EpiMerge, true>(lds, g, S, E, p.wv); }
    { ElGateA El{Z, (u16*)(ws + WS_T1)};
      mini_gemm(lds, (const u16*)(ws + WS_ACAT) + (size_t)MP * 1536, 1536, (const u16*)(ws + WS_WAO), 1536, DM, 512, El, B, G, p.wv); }
    { ElGateB El{Z, (const u16*)(ws + WS_T1), (u16*)(ws + WS_MRG)};
      mini_gemm(lds, (const u16*)(ws + WS_ACAT) + (size_t)MP * 1536 + 512, 1536, (const u16*)(ws + WS_WAO) + 512, 1536, DM, DM, El, B, G, p.wv, nullptr, (const float*)(ws + WS_SS) + (size_t)MP * 4); }
    }
    xcd_barrier(xbar);

    float* STAT = (float*)(ws + WS_CTL + CTL_STAT); const float* C1 = (const float*)(ws + WS_CTL + CTL_C1); const float* C2 = (const float*)(ws + WS_CTL + CTL_C2);
    REP(12) { pg8::Gemm g{(const u16*)(ws + WS_MRG), (const u16*)(ws + WS_WOUT), MP, DM, DM, DM, DM}; pg8::StaticOrder S; S.init(MP, DM, G, B);
      EpiU E{(const u16*)(ws + WS_XB), (u16*)(ws + WS_H1B), STAT};
      pg8::gemm_phase<EpiU, true>(lds, g, S, E, p.wv);
      ElU El{p.in(1), (u16*)(ws + WS_H1B)};
      mini_gemm<ElU, true>(lds, (const u16*)(ws + WS_MRG) + (size_t)MP * DM, DM, (const u16*)(ws + WS_WOUT), DM, DM, DM, El, B, G, p.wv, STAT); }
    xcd_barrier(xbar);

    REP(13) { pg8::Gemm g{(const u16*)(ws + WS_H1B), (const u16*)(ws + WS_WF1), MP, DFF, DM, DM, DM}; pg8::StaticOrder S; S.init(MP, DFF, G, B, 8);
      EpiRelu2LN E{(u16*)(ws + WS_F), STAT, C1, C2};
      pg8::gemm_phase<EpiRelu2LN, true>(lds, g, S, E, p.wv);
      ElRelu2LN El{(u16*)(ws + WS_F), STAT, C1, C2};
      mini_gemm_slab(lds, (const u16*)(ws + WS_H1B) + (size_t)MP * DM, DM, (const u16*)(ws + WS_WF1), DM, DFF, DM, El, B, G, p.wv); }
    xcd_barrier(xbar);

    REP(14) { pg8::Gemm g{(const u16*)(ws + WS_F), (const u16*)(ws + WS_WF2), MP, DM, DFF, DFF, DFF}; pg8::StaticOrder S; S.init(MP, DM, G, B);
      float* STAT2 = (float*)(ws + WS_CTL + CTL_STAT2);
      EpiOut E{(const u16*)(ws + WS_H1B), STAT, p.in(14), p.in(15), (u16*)(ws + WS_U), STAT2};
      pg8::gemm_phase<EpiOut, true>(lds, g, S, E, p.wv);
      ElOut El{(const u16*)(ws + WS_H1B), STAT, p.in(14), p.in(15), (u16*)(ws + WS_U)};
      mini_gemm<ElOut, true>(lds, (const u16*)(ws + WS_F) + (size_t)MP * DFF, DFF, (const u16*)(ws + WS_WF2), DFF, DM, DFF, El, B, G, p.wv, STAT2); }
    xcd_barrier(xbar);

    { const int tid = fresh_tid(p.wv), lane = tid & 63, wave = __builtin_amdgcn_readfirstlane(tid >> 6);
    ln2_rows((const u16*)(ws + WS_U), (const float*)(ws + WS_CTL + CTL_STAT2), p.out() + OFF_Y, p.in(18), p.in(19), B * 8 + wave, G * 8, lane); }
}

extern "C" void kernel_launch(void* const* d_in, const int* in_sizes, int n_in, void* d_out, int out_size, void* d_ws, size_t ws_size, hipStream_t stream) {
    static int grid = 0;
    if (grid == 0) {
        if (n_in != 20 || (size_t)out_size != OUT_TOTAL || ws_size < WS_END) { fprintf(stderr, "kernel_launch: unexpected shapes (n_in %d out %d ws %zu)\n", n_in, out_size, ws_size); grid = -1; return; }
        int dev = 0, cus = 0, per_cu = 0;
        if (hipGetDevice(&dev) != hipSuccess || hipDeviceGetAttribute(&cus, hipDeviceAttributeMultiprocessorCount, dev) != hipSuccess) { grid = -1; return; }
        if (hipFuncSetAttribute((const void*)mk_fwd, hipFuncAttributeMaxDynamicSharedMemorySize, LDS_BYTES) != hipSuccess) { fprintf(stderr, "kernel_launch: hipFuncSetAttribute failed\n"); grid = -1; return; }
        if (hipOccupancyMaxActiveBlocksPerMultiprocessor(&per_cu, (const void*)mk_fwd, 512, LDS_BYTES) != hipSuccess || per_cu < 1) { fprintf(stderr, "kernel_launch: occupancy query says %d\n", per_cu); (void)hipGetLastError(); grid = -1; return; }
        grid = cus;
    }
    if (grid < 0) return;
    if (hipMemsetAsync((char*)d_ws + WS_CTL, 0, CTL_ZERO, stream) != hipSuccess) { fprintf(stderr, "kernel_launch: memset failed\n"); return; }
    if (hipMemsetAsync((char*)d_ws + WS_SS, 0, (size_t)MT * 16, stream) != hipSuccess) { fprintf(stderr, "kernel_launch: memset failed\n"); return; }
    Params p{};
    for (int i = 0; i < 20; ++i) p.in[i] = (const float*)d_in[i];
    p.out = (float*)d_out; p.ws = (unsigned char*)d_ws;
    void* args[] = {&p};
    hipError_t e = hipLaunchCooperativeKernel((const void*)mk_fwd, dim3(grid), dim3(512), args, LDS_BYTES, stream);
    if (e != hipSuccess) fprintf(stderr, "cooperative launch failed: %s (grid %d)\n", hipGetErrorString(e), grid);
}
```

```cpp
#include <hip/hip_runtime.h>
#include <hip/hip_cooperative_groups.h>
#include <cstdio>
#include <cstdint>
namespace cg = cooperative_groups;

typedef unsigned short u16;
typedef short bf16x8 __attribute__((ext_vector_type(8)));
typedef _Float16 half8 __attribute__((ext_vector_type(8)));
typedef float f32x4 __attribute__((ext_vector_type(4)));
typedef float f32x16 __attribute__((ext_vector_type(16)));
typedef unsigned u32x4 __attribute__((ext_vector_type(4)));
typedef unsigned u32x2 __attribute__((ext_vector_type(2)));
#define LAS __attribute__((address_space(3)))

constexpr int DM = 1024, BATCH = 8, SEQ = 4096, DECB = 32, DECS = 8, PAST = 16384, PAGE = 128, NPAGES = 128;
constexpr int MP = BATCH * SEQ, MS = DECB * DECS, MT = MP + MS;
constexpr int TOPK = 256;
constexpr int DFF = 4096;
constexpr int DIN_SRC = 6488, ZW = 6656;
constexpr int QA_OFF = 0, KA_OFF = 512, VA_OFF = 640, QI_OFF = 768, KI_OFF = 1280, WI_OFF = 1344, AB_OFF = 1352, QB_OFF = 1536, KB_OFF = 2048,
              VB_OFF = 2560, GB_OFF = 3584, GA_OFF = 4608, GG_OFF = 5632;
__host__ __device__ __forceinline__ constexpr int gate_lo_off(int c) { return GA_OFF + 256 * (c >> 7) + (c & 127); }
constexpr float DN_ALPHA = 1.189207115002721f;
constexpr float NORM_EPS = 1e-5f;
constexpr float IDX_C = 0.125f * 0.35355339059327373f;
constexpr float QB_SCALE = 0.08838834764831845f;
constexpr float LOG2E = 1.4426950408889634f;
constexpr size_t OFF_Y = 0, OFF_KP = 33816576, OFF_VP = 38010880, OFF_KIP = 42205184, OFF_GP = 44302336, OFF_KS = 45350912, OFF_VS = 45383680,
                 OFF_KIS = 45416448, OFF_GS = 45432832, OUT_TOTAL = 49627136;
constexpr size_t MiB = 1u << 20;
constexpr size_t WS_CTL = 0, WS_WIN = 1 * MiB, WS_WAO = 14 * MiB, WS_WGO = 15 * MiB, WS_WOUT = 17 * MiB, WS_WF1 = 19 * MiB, WS_WF2 = 27 * MiB, WS_WI = 35 * MiB,
                 WS_AB = 37 * MiB, WS_DEC = 40 * MiB, WS_XB = 42 * MiB, WS_Z = 107 * MiB, WS_QT = 527 * MiB, WS_KDT = 560 * MiB, WS_ATT = 594 * MiB,
                 WS_SSC = 611 * MiB, WS_SSM = 739 * MiB, WS_ACAT = 756 * MiB, WS_ORAW = 853 * MiB, WS_T1 = 918 * MiB, WS_MRG = 983 * MiB, WS_U = 1048 * MiB,
                 WS_H1B = 1177 * MiB, WS_K8 = 1242 * MiB, WS_V8 = 1246 * MiB, WS_END = 1250 * MiB, WS_F = WS_Z;
constexpr size_t CTL_STAT = 65536, CTL_C1 = 393216, CTL_C2 = 409600, CTL_STAT2 = 458752, CTL_ZERO = 786432;
constexpr int SSTR = 16448;
constexpr int NCHUNK = 512 + 32;
constexpr int LDS_BYTES = 147456;
#ifndef PROBE_MODE
#define PROBE_MODE 0
#endif
#ifndef DUP_PHASE
#define DUP_PHASE 0
#endif
#define REP(n) for (int rep_ = 0; rep_ < ((DUP_PHASE == (n)) ? 2 : 1); ++rep_)

struct Params { const float* in[20]; float* out; unsigned char* ws; };
typedef __attribute__((address_space(4))) const char* kaptr_t;
typedef const float* cfptr_t; typedef float* fptr_t; typedef unsigned char* ucptr_t;
struct PA {
    kaptr_t ka; int wv;
    __device__ __forceinline__ kaptr_t base() const { kaptr_t b = ka; asm volatile("" : "+s"(b)); return b; }
    __device__ __forceinline__ const float* in(int i) const { return *(const __attribute__((address_space(4))) cfptr_t*)(base() + 8 * i); }
    __device__ __forceinline__ float* out() const { return *(const __attribute__((address_space(4))) fptr_t*)(base() + 160); }
    __device__ __forceinline__ unsigned char* ws() const { return *(const __attribute__((address_space(4))) ucptr_t*)(base() + 168); }
};

typedef float f32x2_cv __attribute__((ext_vector_type(2)));
typedef __bf16 bf16x2_cv __attribute__((ext_vector_type(2)));
__device__ __forceinline__ unsigned pk2bf(float lo, float hi) { const f32x2_cv v = {lo, hi}; const bf16x2_cv b = __builtin_convertvector(v, bf16x2_cv); return __builtin_bit_cast(unsigned, b); }
__device__ __forceinline__ unsigned f2bf(float f) { return pk2bf(f, 0.f) & 0xffffu; }
__device__ __forceinline__ float bf2f(unsigned short b) { return __builtin_bit_cast(float, (unsigned)b << 16); }
__device__ __forceinline__ float bflo(unsigned w) { return __builtin_bit_cast(float, w << 16); }
__device__ __forceinline__ float bfhi(unsigned w) { return __builtin_bit_cast(float, w & 0xffff0000u); }
__device__ __forceinline__ unsigned f2h(float f) { _Float16 h = (_Float16)f; return (unsigned)__builtin_bit_cast(unsigned short, h); }
__device__ __forceinline__ unsigned pk2h(float lo, float hi) { return f2h(lo) | (f2h(hi) << 16); }
__device__ __forceinline__ u32x2 pk8fp8(const f32x4 a, const f32x4 b) {
    int w0 = __builtin_amdgcn_cvt_pk_fp8_f32(a[0], a[1], 0, false); w0 = __builtin_amdgcn_cvt_pk_fp8_f32(a[2], a[3], w0, true);
    int w1 = __builtin_amdgcn_cvt_pk_fp8_f32(b[0], b[1], 0, false); w1 = __builtin_amdgcn_cvt_pk_fp8_f32(b[2], b[3], w1, true);
    return (u32x2){(unsigned)w0, (unsigned)w1};
}
__device__ __forceinline__ u32x2 fp8x4_to_bf16x4(unsigned w) {
    typedef float f32x2_ __attribute__((ext_vector_type(2)));
    const f32x2_ lo = __builtin_amdgcn_cvt_pk_f32_fp8((int)w, false), hi = __builtin_amdgcn_cvt_pk_f32_fp8((int)w, true);
    return (u32x2){(__float_as_uint(lo[0]) >> 16) | (__float_as_uint(lo[1]) & 0xffff0000u), (__float_as_uint(hi[0]) >> 16) | (__float_as_uint(hi[1]) & 0xffff0000u)};
}
__device__ __forceinline__ float sigmoidf_(float x) { return __builtin_amdgcn_rcpf(1.0f + __expf(-x)); }
__device__ __forceinline__ int lane_id() { int l; asm volatile("v_mbcnt_lo_u32_b32 %0, -1, 0\n\tv_mbcnt_hi_u32_b32 %0, -1, %0" : "=v"(l)); return l; }
__device__ __forceinline__ int fresh_tid(int wv) { int t = (wv << 6) | lane_id(); asm volatile("" : "+v"(t)); return t; }
__device__ __forceinline__ float wave_sum(float v) {
#pragma unroll
    for (int o = 1; o < 64; o <<= 1) v += __shfl_xor(v, o);
    return v;
}

#define XB_TMO      128
#define XB_XCNT(j)  (256  + 64 * (j))
#define XB_XSUB(j)  (1280 + 64 * (j))
#define XB_XGEN(j)  (2304 + 64 * (j))
#define XB_TOP      3328
#define XB_TOPGEN   3392
#define XCD_BAR_WORDS 3456
#define XB_SPIN_CAP (1u << 18)
#define XB_EXIT     XCD_BAR_WORDS
__device__ unsigned g_xbar[XCD_BAR_WORDS + 64];

__device__ __forceinline__ unsigned xb_ld(unsigned* p)              { return __hip_atomic_load(p, __ATOMIC_RELAXED, __HIP_MEMORY_SCOPE_AGENT); }
__device__ __forceinline__ unsigned xb_add(unsigned* p, unsigned v) { return __hip_atomic_fetch_add(p, v, __ATOMIC_RELAXED, __HIP_MEMORY_SCOPE_AGENT); }
__device__ __forceinline__ unsigned xb_xcc_id() { return (unsigned)__builtin_amdgcn_s_getreg((3 << 11) | 20) & 0xFu; }
#define XB_SPIN(cond, bar) do { unsigned _sp = 0; while (cond) { __builtin_amdgcn_s_sleep(1); \
    if ((++_sp & 255u) == 0u) { if (xb_ld(&(bar)[XB_TMO])) break; if (_sp > XB_SPIN_CAP) { atomicAdd(&(bar)[XB_TMO], 1u); break; } } } } while (0)

struct XcdBarrier {
    int wv; unsigned* bar; unsigned x;
    volatile LAS unsigned* st;
};

__device__ __forceinline__ XcdBarrier xcd_barrier_post(unsigned* bar, volatile LAS unsigned* st) {
    XcdBarrier b; b.wv = __builtin_amdgcn_readfirstlane(threadIdx.x >> 6); b.bar = bar; b.x = xb_xcc_id(); b.st = st;
    if (threadIdx.x == 0) (void)xb_add(&bar[XB_XCNT(b.x)], 1u);
    return b;
}
__device__ __forceinline__ void xcd_barrier_complete(unsigned* bar, unsigned x, unsigned& nloc, unsigned& nx) {
    const unsigned G = gridDim.x * gridDim.y * gridDim.z;
    unsigned sum, cnt, mine, sp = 0u;
    for (;;) {
        sum = 0u; cnt = 0u; mine = 0u;
#pragma unroll
        for (unsigned j = 0; j < 16; ++j) { const unsigned c = xb_ld(&bar[XB_XCNT(j)]); sum += c; cnt += (c > 0u) ? 1u : 0u; mine = (j == x) ? c : mine; }
        if (sum == G) break;
        __builtin_amdgcn_s_sleep(1);
        if ((++sp & 255u) == 0u) { if (xb_ld(&bar[XB_TMO])) break; if (sp > XB_SPIN_CAP) { atomicAdd(&bar[XB_TMO], 1u); break; } }
    }
    nloc = mine > 0u ? mine : 1u; nx = cnt > 0u ? cnt : 1u;
}

__device__ __forceinline__ void xcd_barrier(const XcdBarrier& b) {
    asm volatile("s_waitcnt vmcnt(0)" ::: "memory");
    __syncthreads();
    if (b.wv == 0 && lane_id() == 0) {
        unsigned* bar = b.bar;
        __builtin_amdgcn_s_waitcnt(0);
        unsigned nloc = b.st[0], nx = b.st[1];
        if (nloc == 0u) { xcd_barrier_complete(bar, b.x, nloc, nx); b.st[0] = nloc; b.st[1] = nx; }
        const unsigned old = xb_add(&bar[XB_XSUB(b.x)], 1u);
        const unsigned gen = old / nloc;
        if (old + 1u == (gen + 1u) * nloc) {
            __builtin_amdgcn_fence(__ATOMIC_RELEASE, "agent");
            asm volatile("s_waitcnt vmcnt(0)" ::: "memory");
            const unsigned og = xb_add(&bar[XB_TOP], 1u);
            const unsigned tg = og / nx;
            if (og + 1u == (tg + 1u) * nx) xb_add(&bar[XB_TOPGEN], 1u);
            else XB_SPIN(xb_ld(&bar[XB_TOPGEN]) == tg, bar);
            __builtin_amdgcn_fence(__ATOMIC_ACQUIRE, "agent");
            xb_add(&bar[XB_XGEN(b.x)], 1u);
            asm volatile("s_waitcnt vmcnt(0)" ::: "memory");
        } else {
            XB_SPIN(xb_ld(&bar[XB_XGEN(b.x)]) == gen, bar);
            __builtin_amdgcn_fence(__ATOMIC_ACQUIRE, "agent");
            asm volatile("s_waitcnt vmcnt(0)" ::: "memory");
        }
    }
    __syncthreads();
}


namespace pg8 {
typedef unsigned short bf16_t;
constexpr int BM = 256, BK = 64, HALF = 128, HTB = HALF * BK * 2, STAGE_BYTES = 8 * HTB, NXCD = 8, WGM = 4;
__host__ __device__ __forceinline__ int lds_byte(int r, int c) { const int st = (r >> 4) * 2 + (c >> 5), rr = r & 15, cc = c & 31, ob = rr * 64 + cc * 2; return st * 1024 + (ob ^ (((ob >> 9) & 1) << 5)); }
__host__ __device__ __forceinline__ void stage_rc(int b, int& R, int& C) { const int st = b / 1024, sb = b % 1024, swz = sb ^ (((sb >> 9) & 1) << 5); R = (st >> 1) * 16 + swz / 64; C = (st & 1) * 32 + (swz % 64) / 2; }
__host__ __device__ __forceinline__ int perm32(int rho) { const int n = rho >> 4, i = rho & 15; return 8 * (i >> 2) + 4 * n + (i & 3); }
struct Unit { int pm, pn; };
struct Gemm { const bf16_t* A; const bf16_t* Bt; int M, N, K, lda, ldb; };
struct StaticOrder {
    int nM, nN, nwg, G, c, wgm;
    __host__ __device__ void init(int M, int N, int G_, int c_, int wgm_ = WGM) { nM = M / BM; nN = N / BM; nwg = nM * nN; G = G_; c = c_; wgm = wgm_; }
    __host__ __device__ bool next(int i, Unit& u) const {
        const long L = (long)i * G + c; if (L >= nwg) return false;
        int wgid = (int)L; { const int q = nwg / NXCD, r = nwg % NXCD, xcd = wgid % NXCD, off = wgid / NXCD; wgid = (xcd < r ? xcd * (q + 1) : r * (q + 1) + (xcd - r) * q) + off; }
        const int nig = wgm * nN, gid = wgid / nig, fm = gid * wgm, gsz = (nM - fm) < wgm ? (nM - fm) : wgm;
        u.pm = fm + ((wgid % nig) % gsz); u.pn = (wgid % nig) / gsz; return true;
    }
};

template <class Epi, bool ALIGN_EPI>
__device__ __forceinline__ void gemm_phase(LAS unsigned char* lds, const Gemm g, const StaticOrder& S, const Epi& E, int wv) {
    int tid_ = (wv << 6) | lane_id(); asm volatile("" : "+v"(tid_));
    const int tid = tid_, wid = __builtin_amdgcn_readfirstlane(tid >> 6), lane = tid & 63, wr = wid >> 2, wc = wid & 3, fr = lane & 15, fq = lane >> 4;
    const int K = g.K, nt = K / BK;
    unsigned voffA[2], voffB[2];
#pragma unroll
    for (int i = 0; i < 2; ++i) { int R, C; stage_rc(tid * 16 + i * 8192, R, C); const int Rb = Epi::PERM ? ((R & ~31) + perm32(R & 31)) : R;
        voffA[i] = (unsigned)(R * g.lda + C) * 2u; voffB[i] = (unsigned)(Rb * g.ldb + C) * 2u; }
    const size_t kstep = (size_t)(BK * 2);
    const size_t hstepA = (size_t)HALF * g.lda * 2, hstepB = (size_t)HALF * g.ldb * 2;
    const size_t tstepA = 2 * hstepA, tstepB = 2 * hstepB;
    const unsigned ldsw = (unsigned)wid * 1024u;
    const int aoff = lds_byte(wr * 64 + fr, fq * 8), boff = lds_byte(wc * 32 + fr, fq * 8);
#define PG8_SA(b, h) (((b) * 2 + (h)) * HTB)
#define PG8_SB(b, h) ((4 + (b) * 2 + (h)) * HTB)
#define PG8_STAGE(bufoff, gbase, voff) do { _Pragma("unroll") for (int _i = 0; _i < 2; ++_i) \
        __builtin_amdgcn_global_load_lds((const unsigned*)((const char*)(gbase) + (voff)[_i]), (LAS unsigned*)(lds + (bufoff) + ldsw + _i * 8192), 16, 0, 0); } while (0)
#define PG8_LDA(dst, b, h) do { _Pragma("unroll") for (int m = 0; m < 4; ++m) _Pragma("unroll") for (int k = 0; k < 2; ++k) dst[m][k] = *(const LAS bf16x8*)(lds + PG8_SA(b, h) + aoff + m * 2048 + k * 1024); } while (0)
#define PG8_LDB(dst, b, h) do { _Pragma("unroll") for (int n = 0; n < 2; ++n) _Pragma("unroll") for (int k = 0; k < 2; ++k) dst[n][k] = *(const LAS bf16x8*)(lds + PG8_SB(b, h) + boff + n * 2048 + k * 1024); } while (0)
#define PG8_MMA(ai, bj, At, Bt) do { __builtin_amdgcn_s_setprio(1); _Pragma("unroll") for (int m = 0; m < 4; ++m) _Pragma("unroll") for (int n = 0; n < 2; ++n) _Pragma("unroll") for (int k = 0; k < 2; ++k) \
        acc[ai][bj][m][n] = __builtin_amdgcn_mfma_f32_16x16x32_bf16(Bt[n][k], At[m][k], acc[ai][bj][m][n], 0, 0, 0); __builtin_amdgcn_s_setprio(0); } while (0)
#define PG8_WAIT_V(n) asm volatile("s_waitcnt vmcnt(" #n ")" ::: "memory")
#define PG8_WAIT_L(n) asm volatile("s_waitcnt lgkmcnt(" #n ")" ::: "memory")
#define PG8_BAR __builtin_amdgcn_s_barrier()
#define PG8_SCHED __builtin_amdgcn_sched_barrier(0)
    Unit cur, nxt; int ui = 0;
    if (!S.next(0, cur)) return;
    f32x4 acc[2][2][4][2];
#pragma unroll
    for (int a = 0; a < 2; ++a)
#pragma unroll
        for (int b = 0; b < 2; ++b)
#pragma unroll
            for (int m = 0; m < 4; ++m)
#pragma unroll
                for (int n = 0; n < 2; ++n) acc[a][b][m][n] = (f32x4){0.f, 0.f, 0.f, 0.f};
    bf16x8 At[4][2], B0[2][2], B1[2][2];
    const char* cA = (const char*)g.A + (size_t)cur.pm * tstepA; const char* cB = (const char*)g.Bt + (size_t)cur.pn * tstepB;
    PG8_STAGE(PG8_SB(0, 0), cB, voffB); PG8_STAGE(PG8_SB(0, 1), cB + hstepB, voffB); PG8_STAGE(PG8_SA(0, 0), cA, voffA); PG8_STAGE(PG8_SA(0, 1), cA + hstepA, voffA);
    if (wr == 1) PG8_BAR;
    PG8_WAIT_V(2); PG8_BAR;
    PG8_STAGE(PG8_SB(1, 0), cB + kstep, voffB); PG8_STAGE(PG8_SA(1, 0), cA + kstep, voffA); PG8_STAGE(PG8_SB(1, 1), cB + hstepB + kstep, voffB);
    PG8_WAIT_V(6); PG8_BAR;
    for (;;) {
        const bool has_next = S.next(ui + 1, nxt);
        const char* nA = has_next ? (const char*)g.A + (size_t)nxt.pm * tstepA : cA; const char* nB = has_next ? (const char*)g.Bt + (size_t)nxt.pn * tstepB : cB;
        constexpr int NSEG = Epi::HOOK_KT > 0 ? 2 : 1;
#pragma unroll
        for (int seg = 0; seg < NSEG; ++seg) {
        if constexpr (Epi::HOOK_KT > 0) { if (seg == 1) { PG8_SCHED; E.hook(acc, cur, wr, wc, fr, fq); PG8_SCHED; } }
        const int tb = seg == 0 ? 0 : Epi::HOOK_KT, te = (NSEG == 2 && seg == 0) ? Epi::HOOK_KT : nt;
        for (int t = tb; t < te; t += 2) {
            const bool last = (t == nt - 2);
            const char* a1 = cA + (size_t)(t + 1) * kstep;
            const char* a2 = last ? nA : cA + (size_t)(t + 2) * kstep; const char* b2 = last ? nB : cB + (size_t)(t + 2) * kstep;
            const char* a3 = a2 + kstep; const char* b3 = b2 + kstep;
            PG8_LDB(B0, 0, 0); PG8_LDB(B1, 0, 1); PG8_SCHED; PG8_LDA(At, 0, 0); PG8_STAGE(PG8_SA(1, 1), a1 + hstepA, voffA);
            PG8_WAIT_V(8); PG8_WAIT_L(0); PG8_BAR; PG8_MMA(0, 0, At, B0); PG8_MMA(0, 1, At, B1); PG8_BAR; PG8_SCHED;
            PG8_LDA(At, 0, 1); PG8_STAGE(PG8_SB(0, 0), b2, voffB); PG8_STAGE(PG8_SB(0, 1), b2 + hstepB, voffB); PG8_STAGE(PG8_SA(0, 0), a2, voffA);
            PG8_WAIT_V(8); PG8_WAIT_L(0); PG8_BAR; PG8_MMA(1, 0, At, B0); PG8_MMA(1, 1, At, B1); PG8_BAR; PG8_SCHED;
            PG8_LDB(B0, 1, 0); PG8_LDB(B1, 1, 1); PG8_SCHED; PG8_LDA(At, 1, 0); PG8_STAGE(PG8_SA(0, 1), a2 + hstepA, voffA);
            PG8_WAIT_V(8); PG8_WAIT_L(0); PG8_BAR; PG8_MMA(0, 0, At, B0); PG8_MMA(0, 1, At, B1); PG8_BAR; PG8_SCHED;
            PG8_LDA(At, 1, 1); PG8_STAGE(PG8_SB(1, 0), b3, voffB); PG8_STAGE(PG8_SB(1, 1), b3 + hstepB, voffB); PG8_STAGE(PG8_SA(1, 0), a3, voffA);
            PG8_WAIT_V(8); PG8_WAIT_L(0); PG8_BAR; PG8_MMA(1, 0, At, B0); PG8_MMA(1, 1, At, B1); PG8_BAR; PG8_SCHED;
        }
        }
        if constexpr (ALIGN_EPI) { if (wr == 0) PG8_BAR; }
        E(acc, cur, wr, wc, fr, fq);
        if (!has_next) break;
#pragma unroll
        for (int a = 0; a < 2; ++a)
#pragma unroll
            for (int b = 0; b < 2; ++b)
#pragma unroll
                for (int m = 0; m < 4; ++m)
#pragma unroll
                    for (int n = 0; n < 2; ++n) acc[a][b][m][n] = (f32x4){0.f, 0.f, 0.f, 0.f};
        cur = nxt; cA = nA; cB = nB; ++ui;
        if constexpr (ALIGN_EPI) { if (wr == 1) PG8_BAR; }
    }
    PG8_WAIT_V(0);
    if constexpr (!ALIGN_EPI) { if (wr == 0) PG8_BAR; }
    PG8_BAR;
#undef PG8_SA
#undef PG8_SB
#undef PG8_STAGE
#undef PG8_LDA
#undef PG8_LDB
#undef PG8_MMA
#undef PG8_WAIT_V
#undef PG8_WAIT_L
#undef PG8_BAR
#undef PG8_SCHED
}
}

#define EPI_LOOP_ROWS _Pragma("unroll") for (int ai = 0; ai < 2; ++ai) _Pragma("unroll") for (int m = 0; m < 4; ++m)

struct EpiZ {
    static constexpr bool PERM = true; static constexpr int HOOK_KT = 0;
    u16* Z; float* out; float* WI; float* AB; unsigned char* K8; unsigned char* V8; int ZS;
    template <int CLS>
    __device__ __forceinline__ void run(const f32x4 (&acc)[2][2][4][2], const pg8::Unit& u, int wr, int wc, int fr, int fq) const {
        const int row0 = u.pm * 256 + wr * 64 + fr, colt = u.pn * 256 + wc * 32 + 8 * fq;
        EPI_LOOP_ROWS {
            const int row = row0 + ai * 128 + m * 16;
#pragma unroll
            for (int bj = 0; bj < 2; ++bj) {
                const int col = colt + bj * 128; const f32x4 v0 = acc[ai][bj][m][0], v1 = acc[ai][bj][m][1];
                if (CLS == 3) {
                    if (col < WI_OFF) {
                        u32x4 w; w.x = pk2h(v0[0], v0[1]); w.y = pk2h(v0[2], v0[3]); w.z = pk2h(v1[0], v1[1]); w.w = pk2h(v1[2], v1[3]);
                        *(u32x4*)(Z + (size_t)row * ZS + col) = w;
                        float* o = out + OFF_KIP + (size_t)row * 64 + (col - KI_OFF);
                        *(f32x4*)o = v0; *(f32x4*)(o + 4) = v1;
                    } else if (col == WI_OFF) { float* o = WI + (size_t)row * 8; *(f32x4*)o = v0; *(f32x4*)(o + 4) = v1; }
                    else if (col < AB_OFF + 16) { float* o = AB + (size_t)row * 16 + (col - AB_OFF); *(f32x4*)o = v0; *(f32x4*)(o + 4) = v1; }
                } else if (CLS == 1) {
                    u32x4 w; w.x = pk2h(v0[0], v0[1]); w.y = pk2h(v0[2], v0[3]); w.z = pk2h(v1[0], v1[1]); w.w = pk2h(v1[2], v1[3]);
                    *(u32x4*)(Z + (size_t)row * ZS + col) = w;
                } else {
                    u32x4 w; w.x = pk2bf(v0[0], v0[1]); w.y = pk2bf(v0[2], v0[3]); w.z = pk2bf(v1[0], v1[1]); w.w = pk2bf(v1[2], v1[3]);
                    *(u32x4*)(Z + (size_t)row * ZS + col) = w;
                    if (CLS == 2) {
                        const int c = col - (bj ? VA_OFF : KA_OFF);
                        float* o = out + (bj ? OFF_VP : OFF_KP) + (size_t)row * 128 + c;
                        *(f32x4*)o = v0; *(f32x4*)(o + 4) = v1;
                        *(u32x2*)((bj ? V8 : K8) + (size_t)row * 128 + c) = pk8fp8(v0, v1);
                    }
                }
            }
        }
    }
    __device__ __forceinline__ void run_gates(const f32x4 (&acc)[2][2][4][2], const pg8::Unit& u, int wr, int wc, int fr, int fq) const {
        const int row0 = u.pm * 256 + wr * 64 + fr, colt = u.pn * 256 + wc * 32 + 8 * fq;
        EPI_LOOP_ROWS {
            const int row = row0 + ai * 128 + m * 16;
            float rho[8], sb[8];
#pragma unroll
            for (int e = 0; e < 8; ++e) {
                const float ga = acc[ai][0][m][e >> 2][e & 3], gg = acc[ai][1][m][e >> 2][e & 3];
                const float eb = __expf(fminf(-gg, 60.f)), ea = __expf(-ga);
                sb[e] = __builtin_amdgcn_rcpf(1.0f + eb); rho[e] = (1.0f + eb) * __builtin_amdgcn_rcpf(1.0f + ea);
            }
            u32x4 w0, w1;
            w0.x = pk2bf(rho[0], rho[1]); w0.y = pk2bf(rho[2], rho[3]); w0.z = pk2bf(rho[4], rho[5]); w0.w = pk2bf(rho[6], rho[7]);
            w1.x = pk2bf(sb[0], sb[1]); w1.y = pk2bf(sb[2], sb[3]); w1.z = pk2bf(sb[4], sb[5]); w1.w = pk2bf(sb[6], sb[7]);
            *(u32x4*)(Z + (size_t)row * ZS + colt) = w0; *(u32x4*)(Z + (size_t)row * ZS + colt + 128) = w1;
        }
    }
    __device__ __forceinline__ void operator()(const f32x4 (&acc)[2][2][4][2], const pg8::Unit& u, int wr, int wc, int fr, int fq) const {
        const int pn = u.pn;
        if (pn >= 18) run_gates(acc, u, wr, wc, fr, fq);
        else if (pn == 2) run<2>(acc, u, wr, wc, fr, fq); else if (pn == 5) run<3>(acc, u, wr, wc, fr, fq); else if (pn == 3 || pn == 4) run<1>(acc, u, wr, wc, fr, fq); else run<0>(acc, u, wr, wc, fr, fq);
    }
};
struct EpiGateA {
    static constexpr bool PERM = true; static constexpr int HOOK_KT = 0;
    const u16* Z; u16* T1;
    __device__ __forceinline__ void operator()(const f32x4 (&acc)[2][2][4][2], const pg8::Unit& u, int wr, int wc, int fr, int fq) const {
        const int row0 = u.pm * 256 + wr * 64 + fr, colt = u.pn * 256 + wc * 32 + 8 * fq;
#pragma unroll
        for (int ai = 0; ai < 2; ++ai) {
            u32x4 gw[4][2];
#pragma unroll
            for (int m = 0; m < 4; ++m)
#pragma unroll
                for (int bj = 0; bj < 2; ++bj) gw[m][bj] = *(const u32x4*)(Z + (size_t)(row0 + ai * 128 + m * 16) * ZW + GA_OFF + colt + bj * 128);
#pragma unroll
            for (int m = 0; m < 4; ++m)
#pragma unroll
                for (int bj = 0; bj < 2; ++bj) {
                    const int row = row0 + ai * 128 + m * 16, col = colt + bj * 128; const f32x4 v0 = acc[ai][bj][m][0], v1 = acc[ai][bj][m][1];
                    const u32x4 g = gw[m][bj];
                    u32x4 w;
                    w.x = pk2bf(v0[0] * sigmoidf_(bflo(g.x)), v0[1] * sigmoidf_(bfhi(g.x))); w.y = pk2bf(v0[2] * sigmoidf_(bflo(g.y)), v0[3] * sigmoidf_(bfhi(g.y)));
                    w.z = pk2bf(v1[0] * sigmoidf_(bflo(g.z)), v1[1] * sigmoidf_(bfhi(g.z))); w.w = pk2bf(v1[2] * sigmoidf_(bflo(g.w)), v1[3] * sigmoidf_(bfhi(g.w)));
                    *(u32x4*)(T1 + (size_t)row * DM + col) = w;
                }
        }
    }
};
struct EpiGateB {
    static constexpr bool PERM = true; static constexpr int HOOK_KT = 0;
    const u16* Z; const u16* T1; u16* MRG;
    __device__ __forceinline__ void operator()(const f32x4 (&acc)[2][2][4][2], const pg8::Unit& u, int wr, int wc, int fr, int fq) const {
        const int row0 = u.pm * 256 + wr * 64 + fr, colt = u.pn * 256 + wc * 32 + 8 * fq;
#pragma unroll
        for (int ai = 0; ai < 2; ++ai) {
            u32x4 gw[4][2], tw[4][2];
#pragma unroll
            for (int m = 0; m < 4; ++m)
#pragma unroll
                for (int bj = 0; bj < 2; ++bj) { const int row = row0 + ai * 128 + m * 16, col = colt + bj * 128;
                    gw[m][bj] = *(const u32x4*)(Z + (size_t)row * ZW + GG_OFF + col); tw[m][bj] = *(const u32x4*)(T1 + (size_t)row * DM + col); }
#pragma unroll
            for (int m = 0; m < 4; ++m)
#pragma unroll
                for (int bj = 0; bj < 2; ++bj) {
                    const int row = row0 + ai * 128 + m * 16, col = colt + bj * 128; const f32x4 v0 = acc[ai][bj][m][0], v1 = acc[ai][bj][m][1];
                    const u32x4 g = gw[m][bj], t = tw[m][bj];
                    u32x4 w;
                    w.x = pk2bf(bflo(t.x) + v0[0] * sigmoidf_(bflo(g.x)), bfhi(t.x) + v0[1] * sigmoidf_(bfhi(g.x)));
                    w.y = pk2bf(bflo(t.y) + v0[2] * sigmoidf_(bflo(g.y)), bfhi(t.y) + v0[3] * sigmoidf_(bfhi(g.y)));
                    w.z = pk2bf(bflo(t.z) + v1[0] * sigmoidf_(bflo(g.z)), bfhi(t.z) + v1[1] * sigmoidf_(bfhi(g.z)));
                    w.w = pk2bf(bflo(t.w) + v1[2] * sigmoidf_(bflo(g.w)), bfhi(t.w) + v1[3] * sigmoidf_(bfhi(g.w)));
                    *(u32x4*)(MRG + (size_t)row * DM + col) = w;
                }
        }
    }
};
struct EpiMerge {
    static constexpr bool PERM = true; static constexpr int HOOK_KT = 8;
    const u16* Z; u16* MRG;
    __device__ __forceinline__ void hook(f32x4 (&acc)[2][2][4][2], const pg8::Unit& u, int wr, int wc, int fr, int fq) const {
        const int row0 = u.pm * 256 + wr * 64 + fr, cg = 512 * u.pn + wc * 32 + 8 * fq;
        const __amdgpu_buffer_rsrc_t zrs = __builtin_amdgcn_make_buffer_rsrc((void*)Z, 0, (int)((size_t)MT * ZW * 2), 0x00020000);
#pragma unroll
        for (int ai = 0; ai < 2; ++ai) {
            __builtin_amdgcn_sched_barrier(0);
            u32x4 rh[4][2];
#pragma unroll
            for (int m = 0; m < 4; ++m) { const unsigned vo = (unsigned)((row0 + ai * 128 + m * 16) * ZW + GA_OFF + cg) * 2u;
                rh[m][0] = __builtin_amdgcn_raw_buffer_load_b128(zrs, vo, 0, 0); rh[m][1] = __builtin_amdgcn_raw_buffer_load_b128(zrs, vo + 512u, 0, 0); }
#pragma unroll
            for (int m = 0; m < 4; ++m)
#pragma unroll
                for (int bj = 0; bj < 2; ++bj) {
                    const u32x4 a = rh[m][bj]; const unsigned aw[4] = {a.x, a.y, a.z, a.w};
#pragma unroll
                    for (int e = 0; e < 4; ++e) { acc[ai][bj][m][e >> 1][2 * (e & 1)] *= bflo(aw[e]); acc[ai][bj][m][e >> 1][2 * (e & 1) + 1] *= bfhi(aw[e]); }
                }
        }
        __builtin_amdgcn_sched_barrier(0);
    }
    __device__ __forceinline__ void operator()(const f32x4 (&acc)[2][2][4][2], const pg8::Unit& u, int wr, int wc, int fr, int fq) const {
        const int row0 = u.pm * 256 + wr * 64 + fr, colt = u.pn * 256 + wc * 32 + 8 * fq, cg = 512 * u.pn + wc * 32 + 8 * fq;
#pragma unroll
        for (int ai = 0; ai < 2; ++ai) {
            u32x4 gw[4][2];
#pragma unroll
            for (int m = 0; m < 4; ++m)
#pragma unroll
                for (int bj = 0; bj < 2; ++bj) gw[m][bj] = *(const u32x4*)(Z + (size_t)(row0 + ai * 128 + m * 16) * ZW + GA_OFF + cg + 256 * bj + 128);
#pragma unroll
            for (int m = 0; m < 4; ++m)
#pragma unroll
                for (int bj = 0; bj < 2; ++bj) {
                    const int row = row0 + ai * 128 + m * 16, col = colt + bj * 128; const f32x4 v0 = acc[ai][bj][m][0], v1 = acc[ai][bj][m][1];
                    const u32x4 g = gw[m][bj];
                    u32x4 w;
                    w.x = pk2bf(v0[0] * bflo(g.x), v0[1] * bfhi(g.x)); w.y = pk2bf(v0[2] * bflo(g.y), v0[3] * bfhi(g.y));
                    w.z = pk2bf(v1[0] * bflo(g.z), v1[1] * bfhi(g.z)); w.w = pk2bf(v1[2] * bflo(g.w), v1[3] * bfhi(g.w));
                    *(u32x4*)(MRG + (size_t)row * DM + col) = w;
                }
        }
    }
};
__device__ __forceinline__ void row_stats(const float* STAT, int row, float& mean, float& rstd) {
    const f32x2_cv st = *(const f32x2_cv*)(STAT + (size_t)row * 2);
    mean = st[0] * (1.0f / DM); const float var = st[1] * (1.0f / DM) - mean * mean; rstd = 1.0f / sqrtf(var + NORM_EPS);
}
struct EpiU {
    static constexpr bool PERM = true; static constexpr int HOOK_KT = 0;
    const u16* X; u16* UB; float* STAT;
    __device__ __forceinline__ void operator()(const f32x4 (&acc)[2][2][4][2], const pg8::Unit& u, int wr, int wc, int fr, int fq) const {
        const int row0 = u.pm * 256 + wr * 64 + fr, colt = u.pn * 256 + wc * 32 + 8 * fq;
#pragma unroll
        for (int ai = 0; ai < 2; ++ai) {
            u32x4 xw[4][2];
#pragma unroll
            for (int m = 0; m < 4; ++m)
#pragma unroll
                for (int bj = 0; bj < 2; ++bj) xw[m][bj] = *(const u32x4*)(X + (size_t)(row0 + ai * 128 + m * 16) * DM + colt + bj * 128);
#pragma unroll
            for (int m = 0; m < 4; ++m) {
                const int row = row0 + ai * 128 + m * 16;
                float s1 = 0.f, s2 = 0.f;
#pragma unroll
                for (int bj = 0; bj < 2; ++bj) {
                    const int col = colt + bj * 128;
                    const u32x4 xb = xw[m][bj];
                    const f32x4 x0 = (f32x4){bflo(xb.x), bfhi(xb.x), bflo(xb.y), bfhi(xb.y)}, x1 = (f32x4){bflo(xb.z), bfhi(xb.z), bflo(xb.w), bfhi(xb.w)};
                    const f32x4 u0 = x0 * DN_ALPHA + acc[ai][bj][m][0], u1 = x1 * DN_ALPHA + acc[ai][bj][m][1];
#pragma unroll
                    for (int e = 0; e < 4; ++e) { s1 += u0[e] + u1[e]; s2 += u0[e] * u0[e] + u1[e] * u1[e]; }
                    u32x4 w; w.x = pk2bf(u0[0], u0[1]); w.y = pk2bf(u0[2], u0[3]); w.z = pk2bf(u1[0], u1[1]); w.w = pk2bf(u1[2], u1[3]);
                    *(u32x4*)(UB + (size_t)row * DM + col) = w;
                }
                s1 += __shfl_xor(s1, 16); s1 += __shfl_xor(s1, 32); s2 += __shfl_xor(s2, 16); s2 += __shfl_xor(s2, 32);
                if (fq == 0) { atomicAdd(STAT + (size_t)row * 2, s1); atomicAdd(STAT + (size_t)row * 2 + 1, s2); }
            }
        }
    }
};
struct EpiRelu2LN {
    static constexpr bool PERM = true; static constexpr int HOOK_KT = 0;
    u16* F; const float* STAT; const float* C1; const float* C2;
    __device__ __forceinline__ void operator()(const f32x4 (&acc)[2][2][4][2], const pg8::Unit& u, int wr, int wc, int fr, int fq) const {
        const int row0 = u.pm * 256 + wr * 64 + fr, colt = u.pn * 256 + wc * 32 + 8 * fq;
        f32x4 c1v[2][2], c2v[2][2];
#pragma unroll
        for (int bj = 0; bj < 2; ++bj)
#pragma unroll
            for (int n = 0; n < 2; ++n) { c1v[bj][n] = *(const f32x4*)(C1 + colt + bj * 128 + 4 * n); c2v[bj][n] = *(const f32x4*)(C2 + colt + bj * 128 + 4 * n); }
        float mean_[2][4], rstd_[2][4];
        EPI_LOOP_ROWS { row_stats(STAT, row0 + ai * 128 + m * 16, mean_[ai][m], rstd_[ai][m]); }
        EPI_LOOP_ROWS {
            const int row = row0 + ai * 128 + m * 16;
            const float mean = mean_[ai][m], rstd = rstd_[ai][m];
#pragma unroll
            for (int bj = 0; bj < 2; ++bj) {
                const int col = colt + bj * 128; f32x4 v0 = (acc[ai][bj][m][0] - c1v[bj][0] * mean) * rstd + c2v[bj][0], v1 = (acc[ai][bj][m][1] - c1v[bj][1] * mean) * rstd + c2v[bj][1];
#pragma unroll
                for (int e = 0; e < 4; ++e) { const float a = fmaxf(v0[e], 0.f), b = fmaxf(v1[e], 0.f); v0[e] = a * a; v1[e] = b * b; }
                u32x4 w; w.x = pk2bf(v0[0], v0[1]); w.y = pk2bf(v0[2], v0[3]); w.z = pk2bf(v1[0], v1[1]); w.w = pk2bf(v1[2], v1[3]);
                *(u32x4*)(F + (size_t)row * DFF + col) = w;
            }
        }
    }
};
struct EpiOut {
    static constexpr bool PERM = true; static constexpr int HOOK_KT = 0;
    const u16* UB; const float* STAT; const float* G1; const float* B1; u16* VB; float* STAT2;
    __device__ __forceinline__ void operator()(const f32x4 (&acc)[2][2][4][2], const pg8::Unit& u, int wr, int wc, int fr, int fq) const {
        const int row0 = u.pm * 256 + wr * 64 + fr, colt = u.pn * 256 + wc * 32 + 8 * fq;
        f32x4 gv[2][2], bv[2][2];
#pragma unroll
        for (int bj = 0; bj < 2; ++bj)
#pragma unroll
            for (int n = 0; n < 2; ++n) { gv[bj][n] = *(const f32x4*)(G1 + colt + bj * 128 + 4 * n); bv[bj][n] = *(const f32x4*)(B1 + colt + bj * 128 + 4 * n); }
#pragma unroll
        for (int aq = 0; aq < 4; ++aq) {
            const int ai = aq >> 1;
            u32x4 uw[2][2]; float mean_[2], rstd_[2];
#pragma unroll
            for (int mm = 0; mm < 2; ++mm) { const int m = (aq & 1) * 2 + mm;
                row_stats(STAT, row0 + ai * 128 + m * 16, mean_[mm], rstd_[mm]);
#pragma unroll
                for (int bj = 0; bj < 2; ++bj) uw[mm][bj] = *(const u32x4*)(UB + (size_t)(row0 + ai * 128 + m * 16) * DM + colt + bj * 128); }
#pragma unroll
            for (int mm = 0; mm < 2; ++mm) {
                const int m = (aq & 1) * 2 + mm;
                const int row = row0 + ai * 128 + m * 16;
                const float mean = mean_[mm], rstd = rstd_[mm];
                float s1 = 0.f, s2 = 0.f;
#pragma unroll
                for (int bj = 0; bj < 2; ++bj) {
                    const int col = colt + bj * 128; const u32x4 ub = uw[mm][bj];
                    const f32x4 u0 = (f32x4){bflo(ub.x), bfhi(ub.x), bflo(ub.y), bfhi(ub.y)}, u1 = (f32x4){bflo(ub.z), bfhi(ub.z), bflo(ub.w), bfhi(ub.w)};
                    const f32x4 v0 = ((u0 - mean) * rstd * gv[bj][0] + bv[bj][0]) * DN_ALPHA + acc[ai][bj][m][0], v1 = ((u1 - mean) * rstd * gv[bj][1] + bv[bj][1]) * DN_ALPHA + acc[ai][bj][m][1];
#pragma unroll
                    for (int e = 0; e < 4; ++e) { s1 += v0[e] + v1[e]; s2 += v0[e] * v0[e] + v1[e] * v1[e]; }
                    u32x4 w; w.x = pk2bf(v0[0], v0[1]); w.y = pk2bf(v0[2], v0[3]); w.z = pk2bf(v1[0], v1[1]); w.w = pk2bf(v1[2], v1[3]);
                    *(u32x4*)(VB + (size_t)row * DM + col) = w;
                }
                s1 += __shfl_xor(s1, 16); s1 += __shfl_xor(s1, 32); s2 += __shfl_xor(s2, 16); s2 += __shfl_xor(s2, 32);
                if (fq == 0) { atomicAdd(STAT2 + (size_t)row * 2, s1); atomicAdd(STAT2 + (size_t)row * 2 + 1, s2); }
            }
        }
    }
};

template <class EpiEl, bool STATS = false>
__device__ __forceinline__ void mini_gemm(LAS unsigned char* lds, const u16* A, int lda, const u16* Bt, int ldb, int N, int K, const EpiEl& E, int vb, int G, int wv, float* STAT = nullptr) {
    const int tid = fresh_tid(wv), lane = tid & 63, wave = __builtin_amdgcn_readfirstlane(tid >> 6), r = lane & 31, hh = lane >> 5;
    LAS float* red = (LAS float*)lds;
    const int ntiles = 8 * (N >> 5), kw = K >> 3;
    for (int t = vb; t < ntiles; t += G) {
        const int tm = t & 7, tn = t >> 3;
        const int lr = lane >> 3, lc = lane & 7;
        LAS unsigned char* wa = lds + 32768 + wave * (64 * 144); LAS unsigned char* wb = wa + 32 * 144;
        const u16* ap = A + (size_t)(32 * tm + lr) * lda + wave * kw + lc * 8;
        const u16* bp = Bt + (size_t)(32 * tn + lr) * ldb + wave * kw + lc * 8;
        u32x4 ra[4], rb[4];
#pragma unroll
        for (int i = 0; i < 4; ++i) { ra[i] = *(const u32x4*)(ap + (size_t)(8 * i) * lda); rb[i] = *(const u32x4*)(bp + (size_t)(8 * i) * ldb); }
        f32x16 acc = {};
#pragma unroll 1
        for (int kb = 0; kb < kw; kb += 64) {
#pragma unroll
            for (int i = 0; i < 4; ++i) { *(LAS u32x4*)(wa + (lr + 8 * i) * 144 + lc * 16) = ra[i]; *(LAS u32x4*)(wb + (lr + 8 * i) * 144 + lc * 16) = rb[i]; }
            const int kn = kb + 64 < kw ? kb + 64 : kb;
#pragma unroll
            for (int i = 0; i < 4; ++i) { ra[i] = *(const u32x4*)(ap + (size_t)(8 * i) * lda + kn); rb[i] = *(const u32x4*)(bp + (size_t)(8 * i) * ldb + kn); }
#pragma unroll
            for (int ks = 0; ks < 4; ++ks) {
                const bf16x8 a = *(const LAS bf16x8*)(wa + r * 144 + (16 * ks + 8 * hh) * 2), b = *(const LAS bf16x8*)(wb + r * 144 + (16 * ks + 8 * hh) * 2);
                acc = __builtin_amdgcn_mfma_f32_32x32x16_bf16(a, b, acc, 0, 0, 0);
            }
        }
        __syncthreads();
#pragma unroll
        for (int rg = 0; rg < 16; ++rg) red[(wave * 16 + rg) * 64 + lane] = acc[rg];
        __syncthreads();
#pragma unroll
        for (int i = 0; i < 2; ++i) {
            const int e = tid + 512 * i, rg = e >> 6, ln = e & 63; float s = 0.f;
#pragma unroll
            for (int w = 0; w < 8; ++w) s += red[(w * 16 + rg) * 64 + ln];
            const int rs = 32 * tm + (rg & 3) + 8 * (rg >> 2) + 4 * (ln >> 5);
            const float uv = E(rs, 32 * tn + (ln & 31), s);
            if (STATS) {
                float s1 = uv, s2 = uv * uv;
#pragma unroll
                for (int o = 1; o < 32; o <<= 1) { s1 += __shfl_xor(s1, o); s2 += __shfl_xor(s2, o); }
                if ((ln & 31) == 0) { atomicAdd(STAT + ((size_t)MP + rs) * 2, s1); atomicAdd(STAT + ((size_t)MP + rs) * 2 + 1, s2); }
            }
        }
    }
    __syncthreads();
}
template <class EpiEl>
__device__ __forceinline__ void mini_gemm64(LAS unsigned char* lds, const u16* A, int lda, const u16* Bt, int ldb, int N, int K, const EpiEl& E, int vb, int G, int wv) {
    const int tid = fresh_tid(wv), lane = tid & 63, wave = __builtin_amdgcn_readfirstlane(tid >> 6), r = lane & 31, hh = lane >> 5;
    LAS float* red = (LAS float*)lds;
    const int ntiles = 4 * (N >> 6), kh = K >> 1, qm = wave & 1, qn = (wave >> 1) & 1, khalf = wave >> 2;
    for (int t = vb; t < ntiles; t += G) {
        const int tm = t & 3, tn = t >> 2;
        const u16* ap = A + (size_t)(64 * tm + 32 * qm + r) * lda + khalf * kh + 8 * hh;
        const u16* bp = Bt + (size_t)(64 * tn + 32 * qn + r) * ldb + khalf * kh + 8 * hh;
        f32x16 acc = {};
#pragma unroll 8
        for (int k = 0; k < kh; k += 16) { const bf16x8 a = *(const bf16x8*)(ap + k), b = *(const bf16x8*)(bp + k); acc = __builtin_amdgcn_mfma_f32_32x32x16_bf16(a, b, acc, 0, 0, 0); }
        __syncthreads();
        if (khalf == 1) {
#pragma unroll
            for (int rg = 0; rg < 16; ++rg) red[((wave & 3) * 16 + rg) * 64 + lane] = acc[rg];
        }
        __syncthreads();
        if (khalf == 0) {
#pragma unroll
            for (int rg = 0; rg < 16; ++rg) {
                const float s = acc[rg] + red[((wave & 3) * 16 + rg) * 64 + lane];
                (void)E(64 * tm + 32 * qm + (rg & 3) + 8 * (rg >> 2) + 4 * hh, 64 * tn + 32 * qn + r, s);
            }
        }
    }
    __syncthreads();
}
template <class EpiEl>
__device__ __forceinline__ void mini_gemm_slab(LAS unsigned char* lds, const u16* A, int lda, const u16* Bt, int ldb, int N, int K, const EpiEl& E, int vb, int G, int wv) {
    const int tid = fresh_tid(wv), lane = tid & 63, wave = __builtin_amdgcn_readfirstlane(tid >> 6), r = lane & 31, hh = lane >> 5, lr = lane >> 3, lc = lane & 7;
    LAS unsigned char* wa = lds + wave * (64 * 144); LAS unsigned char* wb = wa + 32 * 144;
    const int nslab = N >> 5;
    for (int t = vb; t < nslab; t += G) {
        const u16* ap = A + (size_t)(32 * wave + lr) * lda + lc * 8;
        const u16* bp = Bt + (size_t)(32 * t + lr) * ldb + lc * 8;
        u32x4 ra[4], rb[4];
#pragma unroll
        for (int i = 0; i < 4; ++i) { ra[i] = *(const u32x4*)(ap + (size_t)(8 * i) * lda); rb[i] = *(const u32x4*)(bp + (size_t)(8 * i) * ldb); }
        f32x16 acc = {};
#pragma unroll 1
        for (int kb = 0; kb < K; kb += 64) {
#pragma unroll
            for (int i = 0; i < 4; ++i) { *(LAS u32x4*)(wa + (lr + 8 * i) * 144 + lc * 16) = ra[i]; *(LAS u32x4*)(wb + (lr + 8 * i) * 144 + lc * 16) = rb[i]; }
            const int kn = kb + 64 < K ? kb + 64 : kb;
#pragma unroll
            for (int i = 0; i < 4; ++i) { ra[i] = *(const u32x4*)(ap + (size_t)(8 * i) * lda + kn); rb[i] = *(const u32x4*)(bp + (size_t)(8 * i) * ldb + kn); }
#pragma unroll
            for (int ks = 0; ks < 4; ++ks) {
                const bf16x8 a = *(const LAS bf16x8*)(wa + r * 144 + (16 * ks + 8 * hh) * 2), b = *(const LAS bf16x8*)(wb + r * 144 + (16 * ks + 8 * hh) * 2);
                acc = __builtin_amdgcn_mfma_f32_32x32x16_bf16(a, b, acc, 0, 0, 0);
            }
        }
        LAS float* cl = (LAS float*)wa;
#pragma unroll
        for (int rg = 0; rg < 16; ++rg) cl[((rg & 3) + 8 * (rg >> 2) + 4 * hh) * 33 + r] = acc[rg];
#pragma unroll 1
        for (int e = 0; e < 16; ++e) { const int row = 2 * e + hh; (void)E(32 * wave + row, 32 * t + r, cl[row * 33 + r]); }
    }
    __syncthreads();
}
struct ElZ {
    u16* Z; float* out; float* WI; float* AB;
    __device__ __forceinline__ float operator()(int rs, int col, float v) const {
        const size_t row = (size_t)MP + rs;
        if (col >= KI_OFF && col < QB_OFF) {
            if (col < WI_OFF) { Z[row * ZW + col] = (u16)f2h(v); out[OFF_KIS + (size_t)rs * 64 + (col - KI_OFF)] = v; }
            else if (col < AB_OFF) WI[row * 8 + (col - WI_OFF)] = v;
            else if (col < AB_OFF + 16) AB[row * 16 + (col - AB_OFF)] = v;
        } else if (col >= QI_OFF && col < KI_OFF) Z[row * ZW + col] = (u16)f2h(v);
        else if (col >= GA_OFF) Z[row * ZW + col] = (u16)f2bf(sigmoidf_(v));
        else { Z[row * ZW + col] = (u16)f2bf(v);
            if (col >= KA_OFF && col < VA_OFF) out[OFF_KS + (size_t)rs * 128 + (col - KA_OFF)] = v;
            else if (col >= VA_OFF && col < QI_OFF) out[OFF_VS + (size_t)rs * 128 + (col - VA_OFF)] = v; }
        return 0.f;
    }
};
struct ElGateA { const u16* Z; u16* T1;
    __device__ __forceinline__ float operator()(int rs, int col, float v) const { const size_t row = (size_t)MP + rs; T1[row * DM + col] = (u16)f2bf(v * bf2f(Z[row * ZW + gate_lo_off(col)])); return 0.f; } };
struct ElGateB { const u16* Z; const u16* T1; u16* MRG;
    __device__ __forceinline__ float operator()(int rs, int col, float v) const { const size_t row = (size_t)MP + rs; MRG[row * DM + col] = (u16)f2bf(bf2f(T1[row * DM + col]) + v * bf2f(Z[row * ZW + gate_lo_off(col) + 128])); return 0.f; } };
struct ElU { const float* X; u16* UB;
    __device__ __forceinline__ float operator()(int rs, int col, float v) const { const float uu = X[(size_t)rs * DM + col] * DN_ALPHA + v; UB[((size_t)MP + rs) * DM + col] = (u16)f2bf(uu); return uu; } };
struct ElRelu2LN { u16* F; const float* STAT; const float* C1; const float* C2;
    __device__ __forceinline__ float operator()(int rs, int col, float v) const { float mean, rstd; row_stats(STAT, MP + rs, mean, rstd);
        const float a = fmaxf((v - mean * C1[col]) * rstd + C2[col], 0.f); F[((size_t)MP + rs) * DFF + col] = (u16)f2bf(a * a); return 0.f; } };
struct ElOut { const u16* UB; const float* STAT; const float* G1; const float* B1; u16* VB;
    __device__ __forceinline__ float operator()(int rs, int col, float v) const { float mean, rstd; row_stats(STAT, MP + rs, mean, rstd);
        const float h1 = (bf2f(UB[((size_t)MP + rs) * DM + col]) - mean) * rstd * G1[col] + B1[col]; const float vv = h1 * DN_ALPHA + v; VB[((size_t)MP + rs) * DM + col] = (u16)f2bf(vv); return vv; } };

__device__ __forceinline__ int win_src_col(int n) {
    if (n < AB_OFF) return n;
    if (n < AB_OFF + 16) return 4424 + (n - AB_OFF);
    if (n < QB_OFF) return -1;
    if (n < KB_OFF) return 1352 + (n - QB_OFF);
    if (n < VB_OFF) return 1864 + (n - KB_OFF);
    if (n < GB_OFF) return 2376 + (n - VB_OFF);
    if (n < GA_OFF) return 3400 + (n - GB_OFF);
    { const int t = n - GA_OFF, c = 128 * (t >> 8) + (t & 127); return ((t & 128) ? 5464 : 4440) + c; }
}
template <bool MAPPED>
__device__ __forceinline__ void transpose_item(const float* W, int K, int Nsrc, u16* WT, int nblk, LAS float* scr, int item, int lane, const float* kscale = nullptr, int ldw = 0) {
    if (ldw == 0) ldw = K;
    const int kb = item / nblk, nb = item % nblk, k0 = 64 * kb, n0 = 32 * nb;
    const int sc = MAPPED ? win_src_col(n0 + (lane & 31)) : n0 + (lane & 31);
    const int scc = sc >= 0 ? sc : 0;
#pragma unroll
    for (int ib = 0; ib < 32; ib += 16) {
        float wb[16];
#pragma unroll
        for (int i = 0; i < 16; ++i) wb[i] = W[(size_t)(k0 + 2 * (ib + i) + (lane >> 5)) * Nsrc + scc];
#pragma unroll
        for (int i = 0; i < 16; ++i) { const int kk = 2 * (ib + i) + (lane >> 5); float wv = wb[i]; if (MAPPED) { asm volatile("" : "+v"(wv)); if (sc < 0) wv = 0.f; }
            if (kscale) wv *= kscale[k0 + kk]; scr[kk * 33 + (lane & 31)] = wv; }
    }
    asm volatile("s_waitcnt lgkmcnt(0)" ::: "memory");
    const int c = lane & 7;
#pragma unroll
    for (int j = 0; j < 4; ++j) { const int n = (lane >> 3) + 8 * j; const LAS float* s = scr + (8 * c) * 33 + n;
        u32x4 o; o.x = pk2bf(s[0 * 33], s[1 * 33]); o.y = pk2bf(s[2 * 33], s[3 * 33]); o.z = pk2bf(s[4 * 33], s[5 * 33]); o.w = pk2bf(s[6 * 33], s[7 * 33]);
        *(u32x4*)(WT + (size_t)(n0 + n) * ldw + k0 + 8 * c) = o; }
    asm volatile("s_waitcnt lgkmcnt(0)" ::: "memory");
}
__device__ __forceinline__ void phase_prologue(const PA p, LAS unsigned char* lds) {
    const int tid = fresh_tid(p.wv), lane = tid & 63, wave = tid >> 6;
    LAS float* scr = (LAS float*)(lds + wave * 8448);
    const int gw = blockIdx.x * 8 + wave, NGW = gridDim.x * 8;
    unsigned char* ws = p.ws();
    constexpr int I_IN = 16 * (ZW / 32), I_AO = 8 * 32, I_GO = 16 * 32, I_OUT = 16 * 32, I_F1 = 16 * 128, I_F2 = 64 * 32;
    constexpr int NITEMS = I_IN + I_AO + I_GO + I_OUT + I_F1 + I_F2;
    for (int it = gw; it < NITEMS; it += NGW) {
        int r = it;
        if (r < I_IN) { transpose_item<true>(p.in(7), 1024, DIN_SRC, (u16*)(ws + WS_WIN), ZW / 32, scr, r, lane); continue; } r -= I_IN;
        if (r < I_AO) { transpose_item<false>(p.in(11), 512, 1024, (u16*)(ws + WS_WAO), 32, scr, r, lane, nullptr, 1536); continue; } r -= I_AO;
        if (r < I_GO) { transpose_item<false>(p.in(12), 1024, 1024, (u16*)(ws + WS_WAO) + 512, 32, scr, r, lane, nullptr, 1536); continue; } r -= I_GO;
        if (r < I_OUT) { transpose_item<false>(p.in(13), 1024, 1024, (u16*)(ws + WS_WOUT), 32, scr, r, lane); continue; } r -= I_OUT;
        if (r < I_F1) { transpose_item<false>(p.in(16), 1024, 4096, (u16*)(ws + WS_WF1), 128, scr, r, lane, p.in(14)); continue; } r -= I_F1;
        transpose_item<false>(p.in(17), 4096, 1024, (u16*)(ws + WS_WF2), 32, scr, r, lane);
    }
    u16* XB = (u16*)(ws + WS_XB);
    const float* const xprompt = p.in(0); const float* const xsample = p.in(1);
    for (int m = gw; m < MT; m += 4 * NGW) {
        f32x4 v[4][4];
#pragma unroll
        for (int k = 0; k < 4; ++k) { const int mk = m + k * NGW < MT ? m + k * NGW : m;
            const float* xr = mk < MP ? xprompt + (size_t)mk * DM : xsample + (size_t)(mk - MP) * DM; const f32x4* x4 = (const f32x4*)xr + lane;
#pragma unroll
            for (int j = 0; j < 4; ++j) v[k][j] = x4[64 * j]; }
#pragma unroll
        for (int k = 0; k < 4; ++k) {
            if (m + k * NGW >= MT) break;
            u32x2* o2 = (u32x2*)(XB + (size_t)(m + k * NGW) * DM) + lane;
#pragma unroll
            for (int j = 0; j < 4; ++j) { u32x2 o; o.x = pk2bf(v[k][j][0], v[k][j][1]); o.y = pk2bf(v[k][j][2], v[k][j][3]); o2[64 * j] = o; }
        }
    }
}

constexpr int GA_A = 0, GA_QT = 4096, GA_KT = GA_QT + 4 * 64 * 272, GA_END = GA_KT + 4 * 64 * 272;
static_assert(GA_END <= LDS_BYTES - 64, "GLA-A LDS map");
__device__ __forceinline__ void gla_a_chunk(const PA p, LAS unsigned char* lds, int cid) {
    const int tid = fresh_tid(p.wv), lane = tid & 63, wave = __builtin_amdgcn_readfirstlane(tid >> 6);
    unsigned char* ws = p.ws();
    const u16* Z = (const u16*)(ws + WS_Z); const float* AB = (const float*)(ws + WS_AB);
    u16* QT = (u16*)(ws + WS_QT); u16* KDT = (u16*)(ws + WS_KDT); u16* ATT = (u16*)(ws + WS_ATT); float* DEC = (float*)(ws + WS_DEC);
    const int R0 = cid < 512 ? cid * 64 : MP + (cid - 512) * 8, nv = cid < 512 ? 64 : 8;
    LAS float* a_l = (LAS float*)(lds + GA_A);
    const int h = tid >> 7, ch = tid & 127;
    LAS unsigned char* qt_l = lds + GA_QT + h * (64 * 272);
    LAS unsigned char* kt_l = lds + GA_KT + h * (64 * 272);
    __syncthreads();
    {
        u32x4 qraw[8], kraw[8];
#pragma unroll
        for (int i = 0; i < 8; ++i) { const int idx = tid + 512 * i, row = idx >> 6, c16 = idx & 63;
            if (row < nv) { const u16* zp = Z + (size_t)(R0 + row) * ZW + c16 * 8; qraw[i] = *(const u32x4*)(zp + QB_OFF); kraw[i] = *(const u32x4*)(zp + KB_OFF); }
            else { qraw[i] = (u32x4){0u, 0u, 0u, 0u}; kraw[i] = (u32x4){0u, 0u, 0u, 0u}; } }
        for (int i = tid; i < 1024; i += 512) { const int t = i >> 4; a_l[i] = t < nv ? AB[(size_t)(R0 + t) * 16 + (i & 15)] : 0.f; }
#pragma unroll
        for (int i = 0; i < 8; ++i) { const int idx = tid + 512 * i, row = idx >> 6, c16 = idx & 63; const int off = (c16 >> 4) * (64 * 272) + row * 272 + (c16 & 15) * 16;
            *(LAS u32x4*)(lds + GA_QT + off) = qraw[i]; *(LAS u32x4*)(lds + GA_KT + off) = kraw[i]; }
    }
    float w2[16];
#pragma unroll
    for (int r = 0; r < 16; ++r) w2[r] = p.in(8)[r * 512 + h * 128 + ch];
    const float bias = p.in(9)[h * 128 + ch];
    __syncthreads();
    float cum[64]; float run = 0.f;
#pragma unroll
    for (int t = 0; t < 64; ++t) {
        float x = bias;
#pragma unroll
        for (int r4 = 0; r4 < 4; ++r4) { const f32x4 a = *(const LAS f32x4*)(a_l + t * 16 + r4 * 4); x += a[0] * w2[r4 * 4] + a[1] * w2[r4 * 4 + 1] + a[2] * w2[r4 * 4 + 2] + a[3] * w2[r4 * 4 + 3]; }
        float la = (fminf(x, 0.f) - __logf(1.0f + __expf(-fabsf(x)))) * (1.0f / 16.0f);
        if (t >= nv) la = 0.f;
        run += la; cum[t] = run;
    }
    const float last = run; const float elast = __expf(last);
    u16* kdp = KDT + (((size_t)cid * 4 + h) * 128 + ch) * 64;
#pragma unroll
    for (int t8 = 0; t8 < 8; ++t8) {
        unsigned kd[4];
#pragma unroll
        for (int tt = 0; tt < 8; ++tt) {
            const int t = t8 * 8 + tt; const float c = cum[t];
            const float q = bf2f(*(const LAS u16*)(qt_l + t * 272 + ch * 2)), k = bf2f(*(const LAS u16*)(kt_l + t * 272 + ch * 2));
            const float ec = __expf(c), iec = __builtin_amdgcn_rcpf(ec); const float qt = q * QB_SCALE * ec, kt = k * iec, kdv = kt * elast;
            *(LAS u16*)(qt_l + t * 272 + ch * 2) = (u16)f2bf(qt);
            *(LAS u16*)(kt_l + t * 272 + ch * 2) = (u16)f2bf(kt);
            const unsigned kb = f2bf(kdv);
            if (tt & 1) kd[tt >> 1] |= kb << 16; else kd[tt >> 1] = kb;
        }
        *(u32x4*)(kdp + t8 * 8) = (u32x4){kd[0], kd[1], kd[2], kd[3]};
    }
    DEC[((size_t)cid * 4 + h) * 128 + ch] = elast;
    __syncthreads();
#pragma unroll
    for (int i = 0; i < 8; ++i) { const int idx = tid + 512 * i, row = idx >> 6, c16 = idx & 63;
        if (row < nv) *(u32x4*)(QT + (size_t)(R0 + row) * 512 + c16 * 8) = *(const LAS u32x4*)(lds + GA_QT + (c16 >> 4) * (64 * 272) + row * 272 + (c16 & 15) * 16); }
    for (int job = wave; job < 12; job += 8) {
        const int hj = job / 3, tl = job - 3 * hj, ti = tl == 0 ? 0 : 1, tj = tl == 2 ? 1 : 0, r = lane & 31, hh = lane >> 5;
        const LAS unsigned char* qh = lds + GA_QT + hj * (64 * 272); const LAS unsigned char* kh = lds + GA_KT + hj * (64 * 272);
        f32x16 acc = {};
#pragma unroll
        for (int ks = 0; ks < 8; ++ks) {
            const bf16x8 a = *(const LAS bf16x8*)(qh + (32 * ti + r) * 272 + (16 * ks + 8 * hh) * 2);
            const bf16x8 bb = *(const LAS bf16x8*)(kh + (32 * tj + r) * 272 + (16 * ks + 8 * hh) * 2);
            acc = __builtin_amdgcn_mfma_f32_32x32x16_bf16(a, bb, acc, 0, 0, 0);
        }
        u16* ap = ATT + ((size_t)cid * 4 + hj) * 4096;
        const int j = 32 * tj + r;
#pragma unroll
        for (int rg = 0; rg < 16; ++rg) { const int i = 32 * ti + (rg & 3) + 8 * (rg >> 2) + 4 * hh; ap[i * 64 + j] = (u16)f2bf(j <= i ? acc[rg] : 0.f); }
    }
}

constexpr int SS_GRP = 3, SS_ITEMS = DECB * ((NPAGES + 1) / SS_GRP);
static_assert((NPAGES + 1) % SS_GRP == 0, "page groups");
__device__ __forceinline__ void sample_scores_tile(const half8 (&af)[2][4], const float (&wv)[2][16], const half8 (&bfr)[4], float* srow, int r, int hh) {
#pragma unroll
    for (int rb = 0; rb < 2; ++rb) {
        f32x16 acc = {};
#pragma unroll
        for (int ks = 0; ks < 4; ++ks) acc = __builtin_amdgcn_mfma_f32_32x32x16_f16(af[rb][ks], bfr[ks], acc, 0, 0, 0);
#pragma unroll
        for (int tl = 0; tl < 4; ++tl) {
            float s = 0.f;
#pragma unroll
            for (int e = 0; e < 4; ++e) s = fmaf(fmaxf(acc[4 * tl + e], 0.f), wv[rb][4 * tl + e], s);
            s += __shfl_xor(s, 32);
            if (hh == 0) srow[(size_t)(4 * rb + tl) * SSTR + r] = s;
        }
    }
}
__device__ __forceinline__ void sample_scores_phase(const PA p, int lane) {
    unsigned char* ws = p.ws();
    const u16* Z = (const u16*)(ws + WS_Z); const float* WI = (const float*)(ws + WS_WI); float* SSM = (float*)(ws + WS_SSM);
    const int* ptab = (const int*)p.in(6);
    unsigned* ctr = (unsigned*)(ws + WS_CTL + 32768);
    const int r = lane & 31, hh = lane >> 5;
    int cur_bs = -1;
    half8 af[2][4]; float wv[2][16];
    for (;;) {
        unsigned it = 0u; if (lane == 0) it = atomicAdd(ctr, 1u);
        it = (unsigned)__builtin_amdgcn_readfirstlane((int)it);
        if (it >= (unsigned)SS_ITEMS) break;
        const int bs = (int)it / ((NPAGES + 1) / SS_GRP), pg0 = ((int)it % ((NPAGES + 1) / SS_GRP)) * SS_GRP;
        if (bs != cur_bs) {
            cur_bs = bs;
#pragma unroll
            for (int rb = 0; rb < 2; ++rb) {
                const int tok = 4 * rb + (r >> 3), head = r & 7;
                const u16* qp = Z + (size_t)(MP + bs * 8 + tok) * ZW + QI_OFF + head * 64 + 8 * hh;
#pragma unroll
                for (int ks = 0; ks < 4; ++ks) af[rb][ks] = *(const half8*)(qp + 16 * ks);
#pragma unroll
                for (int tl = 0; tl < 4; ++tl) { const f32x4 w4 = *(const f32x4*)(WI + (size_t)(MP + bs * 8 + 4 * rb + tl) * 8 + 4 * hh);
#pragma unroll
                    for (int e = 0; e < 4; ++e) wv[rb][4 * tl + e] = w4[e] * IDX_C; }
            }
        }
#pragma unroll 1
        for (int pg = pg0; pg < pg0 + SS_GRP; ++pg) {
            float* srow = SSM + (size_t)(bs * 8) * SSTR + pg * PAGE;
            if (pg < NPAGES) {
                const float* kp = p.in(4) + ((size_t)ptab[bs * NPAGES + pg] * PAGE + r) * 64 + 8 * hh;
                f32x4 x[4][4][2];
#pragma unroll
                for (int kt = 0; kt < 4; ++kt)
#pragma unroll
                    for (int ks = 0; ks < 4; ++ks) { x[kt][ks][0] = *(const f32x4*)(kp + kt * 32 * 64 + 16 * ks); x[kt][ks][1] = *(const f32x4*)(kp + kt * 32 * 64 + 16 * ks + 4); }
#pragma unroll
                for (int kt = 0; kt < 4; ++kt) {
                    half8 bfr[4];
#pragma unroll
                    for (int ks = 0; ks < 4; ++ks) { const f32x4 x0 = x[kt][ks][0], x1 = x[kt][ks][1];
                        bfr[ks] = (half8){(_Float16)x0[0], (_Float16)x0[1], (_Float16)x0[2], (_Float16)x0[3], (_Float16)x1[0], (_Float16)x1[1], (_Float16)x1[2], (_Float16)x1[3]}; }
                    sample_scores_tile(af, wv, bfr, srow + kt * 32, r, hh);
                }
            } else {
                half8 bfr[4];
                const u16* kp = Z + (size_t)(MP + bs * 8 + (r & 7)) * ZW + KI_OFF + 8 * hh;
#pragma unroll
                for (int ks = 0; ks < 4; ++ks) bfr[ks] = *(const half8*)(kp + 16 * ks);
                sample_scores_tile(af, wv, bfr, srow, r, hh);
            }
        }
    }
}

__device__ __forceinline__ unsigned okey(float f) { unsigned u = __builtin_bit_cast(unsigned, f); if (u == 0x80000000u) u = 0u; return (u & 0x80000000u) ? ~u : (u | 0x80000000u); }
__device__ __forceinline__ void hist_find(const LAS unsigned* hist, int bpl, int r, int lane, unsigned& dsel, unsigned& cab) {
    unsigned tot = 0u;
    for (int j = 0; j < bpl; ++j) tot += hist[lane * bpl + j];
    unsigned suf = tot;
#pragma unroll
    for (int o = 1; o < 64; o <<= 1) { const unsigned t = __shfl_down(suf, o); if (lane + o < 64) suf += t; }
    const unsigned above = suf - tot;
    const bool mine = (above < (unsigned)r) && ((unsigned)r <= above + tot);
    unsigned d = 0u, cb = 0u;
    if (mine) { unsigned cumv = above; for (int j = bpl - 1; j >= 0; --j) { const unsigned cnt = hist[lane * bpl + j]; if (cumv + cnt >= (unsigned)r) { d = (unsigned)(lane * bpl + j); cb = cumv; break; } cumv += cnt; } }
    const unsigned long long bm = __ballot(mine);
    const int src = __ffsll((long long)bm) - 1;
    dsel = (unsigned)__shfl((int)d, src); cab = (unsigned)__shfl((int)cb, src);
}
__device__ __forceinline__ int select_topk_block(const float* scores, int n, LAS unsigned* hist, LAS unsigned* sel, LAS unsigned* xch, int tid) {
    const int lane = tid & 63, wave = __builtin_amdgcn_readfirstlane(tid >> 6);
    constexpr int SEG = 33 * 64;
    unsigned key[33];
    {
        float sv[33];
#pragma unroll
        for (int c = 0; c < 33; ++c) { const int i = wave * SEG + c * 64 + lane; sv[c] = scores[i < n ? i : n - 1]; }
#pragma unroll
        for (int c = 0; c < 33; ++c) { const int i = wave * SEG + c * 64 + lane; float v = sv[c]; asm volatile("" : "+v"(v)); key[c] = i < n ? okey(v) : 0u; }
    }
    unsigned prefix = 0u, pmask = 0u; int r = TOPK;
#pragma unroll 1
    for (int level = 0; level < 3; ++level) {
        const int shift = level == 0 ? 21 : (level == 1 ? 10 : 0), nb = level == 2 ? 1024 : 2048;
        const unsigned bmask = (unsigned)(nb - 1);
        for (int i = tid; i < 2048; i += 512) hist[i] = 0u;
        __syncthreads();
#pragma unroll
        for (int c = 0; c < 33; ++c) { const unsigned k = key[c]; if ((k & pmask) == prefix) atomicAdd((unsigned*)(hist + ((k >> shift) & bmask)), 1u); }
        __syncthreads();
        if (wave == 0) { unsigned dsel, cab; hist_find(hist, nb >> 6, r, lane, dsel, cab); if (lane == 0) { xch[0] = dsel; xch[1] = cab; } }
        __syncthreads();
        const unsigned dsel = xch[0], cab = xch[1];
        prefix |= dsel << shift; pmask |= bmask << shift; r -= (int)cab;
    }
    int cgt = 0, ceq = 0;
#pragma unroll
    for (int c = 0; c < 33; ++c) { const unsigned k = key[c]; cgt += __popcll(__ballot(k > prefix)); ceq += __popcll(__ballot(k == prefix)); }
    if (lane == 0) { xch[2 + wave] = (unsigned)cgt; xch[10 + wave] = (unsigned)ceq; }
    __syncthreads();
    int pos = 0, eqt = 0;
    for (int w2 = 0; w2 < wave; ++w2) { const int g2 = (int)xch[2 + w2], e2 = (int)xch[10 + w2]; int te = r - eqt; te = te < 0 ? 0 : (te > e2 ? e2 : te); pos += g2 + te; eqt += e2; }
    const unsigned long long ltm = (1ull << lane) - 1ull;
#pragma unroll
    for (int c = 0; c < 33; ++c) {
        const unsigned k = key[c]; const bool gt = k > prefix, eq = k == prefix;
        const unsigned long long em = __ballot(eq);
        const bool take = gt || (eq && (eqt + __popcll(em & ltm) < r));
        const unsigned long long tm = __ballot(take);
        if (take) { const int pp = pos + __popcll(tm & ltm); if (pp < TOPK) sel[pp] = (unsigned)(wave * SEG + c * 64 + lane); }
        pos += __popcll(tm); eqt += __popcll(em);
    }
    __syncthreads();
    return TOPK;
}

struct KVPrompt {
    const u16* Z; size_t row0;
    __device__ __forceinline__ bf16x8 k8(int key, int g, int d) const { return *(const bf16x8*)(Z + (row0 + key) * ZW + KA_OFF + g * 64 + d); }
    __device__ __forceinline__ bf16x8 v8(int key, int g, int d) const { return *(const bf16x8*)(Z + (row0 + key) * ZW + VA_OFF + g * 64 + d); }
};
__device__ __forceinline__ bf16x8 cvt8(const float* p) {
    const f32x4 a = *(const f32x4*)p, b = *(const f32x4*)(p + 4); u32x4 w; w.x = pk2bf(a[0], a[1]); w.y = pk2bf(a[2], a[3]); w.z = pk2bf(b[0], b[1]); w.w = pk2bf(b[2], b[3]);
    return __builtin_bit_cast(bf16x8, w);
}
struct KVSample {
    const float* ck; const float* cv; const float* nk; const float* nv; const int* pt;
    __device__ __forceinline__ unsigned code(int key) const { return key < PAST ? (unsigned)(pt[key >> 7] * PAGE + (key & 127)) : (0x80000000u | (unsigned)(key - PAST)); }
    __device__ __forceinline__ const float* rowp(const float* cache, const float* nw, int c) const {
        return c >= 0 ? cache + (size_t)c * 128 : nw + (size_t)(c & 0x7fffffff) * 128; }
    __device__ __forceinline__ bf16x8 k8(int key, int g, int d) const { return cvt8(rowp(ck, nk, key) + g * 64 + d); }
    __device__ __forceinline__ bf16x8 v8(int key, int g, int d) const { return cvt8(rowp(cv, nv, key) + g * 64 + d); }
};
template <class KV, int QKB, int PVB>
__device__ __forceinline__ void sparse_attn_g(const u16* zq, const KV& kv, const LAS unsigned* sel, int count, LAS float* pbuf, u16* orow, int lane, int g) {
    const int col = lane & 15, kq = lane >> 4;
    bf16x8 bq0 = {}, bq1 = {};
    if (col < 4) { const u16* qp = zq + QA_OFF + (4 * g + col) * 64 + 8 * kq; bq0 = *(const bf16x8*)qp; bq1 = *(const bf16x8*)(qp + 32); }
    float mx = -INFINITY;
#pragma unroll 1
    for (int jb = 0; jb < 16; jb += QKB) {
        bf16x8 ka[QKB][2];
#pragma unroll
        for (int j = 0; j < QKB; ++j) { const int key = (int)sel[16 * (jb + j) + col]; ka[j][0] = kv.k8(key, g, 8 * kq); ka[j][1] = kv.k8(key, g, 32 + 8 * kq); }
#pragma unroll
        for (int j = 0; j < QKB; ++j) {
            f32x4 acc = {};
            acc = __builtin_amdgcn_mfma_f32_16x16x32_bf16(ka[j][0], bq0, acc, 0, 0, 0);
            acc = __builtin_amdgcn_mfma_f32_16x16x32_bf16(ka[j][1], bq1, acc, 0, 0, 0);
#pragma unroll
            for (int e = 0; e < 4; ++e) { const int slot = 16 * (jb + j) + 4 * kq + e; const float v = slot < count ? acc[e] * (0.125f * LOG2E) : -INFINITY; mx = fmaxf(mx, v);
                if (col < 4) pbuf[slot * 4 + col] = v; }
        }
    }
    mx = fmaxf(mx, __shfl_xor(mx, 16)); mx = fmaxf(mx, __shfl_xor(mx, 32));
    float mh[4], sh[4];
#pragma unroll
    for (int hq = 0; hq < 4; ++hq) { mh[hq] = __shfl(mx, hq); sh[hq] = 0.f; }
    asm volatile("s_waitcnt lgkmcnt(0)" ::: "memory");
#pragma unroll
    for (int i = 0; i < 4; ++i) { LAS f32x4* pp = (LAS f32x4*)(pbuf + (lane + 64 * i) * 4); f32x4 v = *pp;
#pragma unroll
        for (int hq = 0; hq < 4; ++hq) { v[hq] = __builtin_amdgcn_exp2f(v[hq] - mh[hq]); sh[hq] += v[hq]; }
        *pp = v; }
#pragma unroll
    for (int hq = 0; hq < 4; ++hq) sh[hq] = 1.0f / wave_sum(sh[hq]);
    asm volatile("s_waitcnt lgkmcnt(0)" ::: "memory");
    const int ksub = lane >> 3, dc = lane & 7;
    float o[4][8];
#pragma unroll
    for (int hq = 0; hq < 4; ++hq)
#pragma unroll
        for (int e = 0; e < 8; ++e) o[hq][e] = 0.f;
#pragma unroll 1
    for (int ib = 0; ib < 32; ib += PVB) {
        bf16x8 vv[PVB];
#pragma unroll
        for (int j = 0; j < PVB; ++j) { const int key = (int)sel[8 * (ib + j) + ksub]; vv[j] = kv.v8(key, g, 8 * dc); }
#pragma unroll
        for (int j = 0; j < PVB; ++j) {
            const f32x4 pp = *(const LAS f32x4*)(pbuf + (8 * (ib + j) + ksub) * 4);
#pragma unroll
            for (int e = 0; e < 8; ++e) { const float vf = bf2f((u16)vv[j][e]);
#pragma unroll
                for (int hq = 0; hq < 4; ++hq) o[hq][e] = fmaf(pp[hq], vf, o[hq][e]); }
        }
    }
#pragma unroll
    for (int hq = 0; hq < 4; ++hq)
#pragma unroll
        for (int e = 0; e < 8; ++e) { float x = o[hq][e]; x += __shfl_xor(x, 8); x += __shfl_xor(x, 16); x += __shfl_xor(x, 32); o[hq][e] = x * sh[hq]; }
    if (ksub == 0) {
#pragma unroll
        for (int hq = 0; hq < 4; ++hq) { u32x4 w; w.x = pk2bf(o[hq][0], o[hq][1]); w.y = pk2bf(o[hq][2], o[hq][3]); w.z = pk2bf(o[hq][4], o[hq][5]); w.w = pk2bf(o[hq][6], o[hq][7]);
            *(u32x4*)(orow + (4 * g + hq) * 64 + 8 * dc) = w; }
    }
    asm volatile("s_waitcnt lgkmcnt(0)" ::: "memory");
}

template <class KV>
__device__ __forceinline__ void sparse_attn_part(const u16* zq, const KV& kv, const LAS unsigned* sel, int slot0, LAS float* pbuf, LAS float* part, int lane, int g) {
    const int col = lane & 15, kq = lane >> 4;
    bf16x8 bq0 = {}, bq1 = {};
    if (col < 4) { const u16* qp = zq + QA_OFF + (4 * g + col) * 64 + 8 * kq; bq0 = *(const bf16x8*)qp; bq1 = *(const bf16x8*)(qp + 32); }
    bf16x8 ka[4][2];
#pragma unroll
    for (int j = 0; j < 4; ++j) { const int key = (int)sel[slot0 + 16 * j + col]; ka[j][0] = kv.k8(key, g, 8 * kq); ka[j][1] = kv.k8(key, g, 32 + 8 * kq); }
    const int ksub = lane >> 3, dc = lane & 7;
    bf16x8 vv[8];
#pragma unroll
    for (int j = 0; j < 8; ++j) { const int key = (int)sel[slot0 + 8 * j + ksub]; vv[j] = kv.v8(key, g, 8 * dc); }
    float mx = -INFINITY;
    f32x4 lg[4];
#pragma unroll
    for (int j = 0; j < 4; ++j) {
        f32x4 acc = {};
        acc = __builtin_amdgcn_mfma_f32_16x16x32_bf16(ka[j][0], bq0, acc, 0, 0, 0);
        acc = __builtin_amdgcn_mfma_f32_16x16x32_bf16(ka[j][1], bq1, acc, 0, 0, 0);
#pragma unroll
        for (int e = 0; e < 4; ++e) { acc[e] *= (0.125f * LOG2E); mx = fmaxf(mx, acc[e]); }
        lg[j] = acc;
    }
    mx = fmaxf(mx, __shfl_xor(mx, 16)); mx = fmaxf(mx, __shfl_xor(mx, 32));
    float sm = 0.f;
#pragma unroll
    for (int j = 0; j < 4; ++j)
#pragma unroll
        for (int e = 0; e < 4; ++e) { const float pv = __builtin_amdgcn_exp2f(lg[j][e] - mx); sm += pv; if (col < 4) pbuf[(16 * j + 4 * kq + e) * 4 + col] = pv; }
    sm += __shfl_xor(sm, 16); sm += __shfl_xor(sm, 32);
    if (lane < 4) { part[lane] = mx; part[4 + lane] = sm; }
    asm volatile("s_waitcnt lgkmcnt(0)" ::: "memory");
    float o[4][8];
#pragma unroll
    for (int hq = 0; hq < 4; ++hq)
#pragma unroll
        for (int e = 0; e < 8; ++e) o[hq][e] = 0.f;
#pragma unroll
    for (int j = 0; j < 8; ++j) {
        const f32x4 pp = *(const LAS f32x4*)(pbuf + (8 * j + ksub) * 4);
#pragma unroll
        for (int e = 0; e < 8; ++e) { const float vf = bf2f((u16)vv[j][e]);
#pragma unroll
            for (int hq = 0; hq < 4; ++hq) o[hq][e] = fmaf(pp[hq], vf, o[hq][e]); }
    }
#pragma unroll
    for (int hq = 0; hq < 4; ++hq)
#pragma unroll
        for (int e = 0; e < 8; ++e) { float x = o[hq][e]; x += __shfl_xor(x, 8); x += __shfl_xor(x, 16); x += __shfl_xor(x, 32); o[hq][e] = x; }
    if (ksub == 0) {
#pragma unroll
        for (int hq = 0; hq < 4; ++hq) { *(LAS f32x4*)(part + 8 + hq * 64 + 8 * dc) = (f32x4){o[hq][0], o[hq][1], o[hq][2], o[hq][3]}; *(LAS f32x4*)(part + 8 + hq * 64 + 8 * dc + 4) = (f32x4){o[hq][4], o[hq][5], o[hq][6], o[hq][7]}; }
    }
}
__device__ __forceinline__ void attn_combine(const LAS float* part0, u16* orow, int lane, int g) {
#pragma unroll
    for (int hq = 0; hq < 4; ++hq) {
        float m = -INFINITY;
#pragma unroll
        for (int q = 0; q < 4; ++q) m = fmaxf(m, part0[q * 264 + hq]);
        float l = 0.f, ov = 0.f;
#pragma unroll
        for (int q = 0; q < 4; ++q) { const float sc = __builtin_amdgcn_exp2f(part0[q * 264 + hq] - m); l += part0[q * 264 + 4 + hq] * sc; ov += part0[q * 264 + 8 + hq * 64 + lane] * sc; }
        orow[(4 * g + hq) * 64 + lane] = (u16)f2bf(ov / l);
    }
}

__device__ __forceinline__ bf16x8 tr_pair(const LAS unsigned char* plo, const LAS unsigned char* phi) {
    typedef short v4i16_t __attribute__((ext_vector_type(4)));
    const v4i16_t lo = __builtin_amdgcn_ds_read_tr16_b64_v4i16((LAS v4i16_t*)plo), hi = __builtin_amdgcn_ds_read_tr16_b64_v4i16((LAS v4i16_t*)phi);
    return (bf16x8){lo[0], lo[1], lo[2], lo[3], hi[0], hi[1], hi[2], hi[3]};
}
constexpr int VST_ROW = 160, VST_BYTES = 64 * VST_ROW;
__device__ __forceinline__ void attn_wave(const u16* Z, const unsigned char* K8, const unsigned char* V8, size_t rowb, int q0w  , const LAS unsigned char* selw  , int wave,
                                          const LAS unsigned* ST, LAS unsigned char* vst, u16* ACAT, int lane) {
    const int col = lane & 15, kq = lane >> 4, li = lane & 15;
    const LAS unsigned char* trb = vst + (4 * kq + (li >> 2)) * VST_ROW + (li & 3) * 8;
    LAS unsigned char* wrb = vst + (lane >> 3) * VST_ROW + (lane & 7) * 16;
    u32x4 ka[16], vr[8], qr[2];
#define AT_SEL(QG) ((const LAS unsigned*)(selw + ((QG) >> 1) * 1024))
#define AT_ISSUE_K(QG, J0) do { const LAS unsigned* sl_ = AT_SEL(QG); const unsigned char* kb_ = K8 + rowb * 128 + ((QG) & 1) * 64 + 16 * kq; \
        _Pragma("unroll") for (int j = (J0); j < (J0) + 8; ++j) { const int key = (int)sl_[16 * j + col]; ka[j] = *(const u32x4*)(kb_ + (size_t)key * 128); } } while (0)
#define AT_ISSUE_V(QG, C) do { const LAS unsigned* sl_ = AT_SEL(QG); const u16* vb_ = Z + rowb * ZW + VA_OFF + ((QG) & 1) * 64 + 8 * (lane & 7); \
        _Pragma("unroll") for (int i = 0; i < 8; ++i) { const int key = (int)sl_[64 * (C) + 8 * i + (lane >> 3)]; vr[i] = *(const u32x4*)(vb_ + (size_t)key * ZW); } } while (0)
    AT_ISSUE_K(0, 0); AT_ISSUE_V(0, 0);
#pragma unroll 1
    for (int qg = 0; qg < 8; ++qg) {
        const int qq = qg >> 1, g = qg & 1;
        const int count = (int)ST[(wave * 4 + qq) * 4 + 2];
        AT_ISSUE_K(qg, 8);
        { const u16* qp_ = Z + (rowb + q0w + qq) * ZW + QA_OFF + (4 * g + (col & 3)) * 64 + 16 * kq; qr[0] = *(const u32x4*)qp_; qr[1] = *(const u32x4*)(qp_ + 8); }
        long bq0 = 0, bq1 = 0;
        if (col < 4) {
            const u32x2 a = pk8fp8((f32x4){bflo(qr[0].x), bfhi(qr[0].x), bflo(qr[0].y), bfhi(qr[0].y)}, (f32x4){bflo(qr[0].z), bfhi(qr[0].z), bflo(qr[0].w), bfhi(qr[0].w)});
            const u32x2 b = pk8fp8((f32x4){bflo(qr[1].x), bfhi(qr[1].x), bflo(qr[1].y), bfhi(qr[1].y)}, (f32x4){bflo(qr[1].z), bfhi(qr[1].z), bflo(qr[1].w), bfhi(qr[1].w)});
            bq0 = (long)(((unsigned long long)a.y << 32) | a.x); bq1 = (long)(((unsigned long long)b.y << 32) | b.x);
        }
        f32x4 lg[16];
#pragma unroll
        for (int j = 0; j < 16; ++j) {
            const long a0 = (long)(((unsigned long long)ka[j].y << 32) | ka[j].x), a1 = (long)(((unsigned long long)ka[j].w << 32) | ka[j].z);
            f32x4 acc = {}; acc = __builtin_amdgcn_mfma_f32_16x16x32_fp8_fp8(a0, bq0, acc, 0, 0, 0); lg[j] = __builtin_amdgcn_mfma_f32_16x16x32_fp8_fp8(a1, bq1, acc, 0, 0, 0);
        }
        if (count < TOPK) {
#pragma unroll
            for (int jg = 0; jg < 16; ++jg)
#pragma unroll
                for (int e = 0; e < 4; ++e) { const int slot = 16 * jg + 4 * kq + e; if (slot >= count) lg[jg][e] = -INFINITY; }
        }
        float mx = -INFINITY;
#pragma unroll
        for (int jg = 0; jg < 16; ++jg)
#pragma unroll
            for (int e = 0; e < 4; ++e) mx = fmaxf(mx, lg[jg][e]);
        mx = fmaxf(mx, __shfl_xor(mx, 16)); mx = fmaxf(mx, __shfl_xor(mx, 32));
        const float nmc = -mx * (0.125f * LOG2E);
        float sm = 0.f;
        unsigned pk[16][2];
#pragma unroll
        for (int jg = 0; jg < 16; ++jg) {
            float pv[4];
#pragma unroll
            for (int e = 0; e < 4; ++e) { pv[e] = __builtin_amdgcn_exp2f(fmaf(lg[jg][e], 0.125f * LOG2E, nmc)); sm += pv[e]; }
            pk[jg][0] = pk2bf(pv[0], pv[1]); pk[jg][1] = pk2bf(pv[2], pv[3]);
        }
        sm += __shfl_xor(sm, 16); sm += __shfl_xor(sm, 32);
        const float inv = 1.0f / sm;
        __builtin_amdgcn_sched_barrier(0);
        if (qg < 7) AT_ISSUE_K(qg + 1, 0);
        __builtin_amdgcn_sched_barrier(0);
        f32x4 oacc[4];
#pragma unroll
        for (int dg = 0; dg < 4; ++dg) oacc[dg] = (f32x4){0.f, 0.f, 0.f, 0.f};
#pragma unroll
        for (int c = 0; c < 4; ++c) {
#pragma unroll
            for (int i = 0; i < 8; ++i) *(LAS u32x4*)(wrb + 8 * i * VST_ROW) = vr[i];
            __builtin_amdgcn_sched_barrier(0);
            if (c < 3) AT_ISSUE_V(qg, c + 1); else if (qg < 7) AT_ISSUE_V(qg + 1, 0);
            asm volatile("s_waitcnt lgkmcnt(0)" ::: "memory");
            __builtin_amdgcn_sched_barrier(0);
#pragma unroll
            for (int s = 0; s < 2; ++s) {
                if (s) __builtin_amdgcn_sched_barrier(0);
                const int jg = 4 * c + 2 * s;
                const u32x4 bw = (u32x4){pk[jg][0], pk[jg][1], pk[jg + 1][0], pk[jg + 1][1]};
                const bf16x8 bfrag = __builtin_bit_cast(bf16x8, bw);
#pragma unroll
                for (int dg = 0; dg < 4; ++dg) {
                    const bf16x8 afrag = tr_pair(trb + (32 * s) * VST_ROW + dg * 32, trb + (32 * s + 16) * VST_ROW + dg * 32);
                    oacc[dg] = __builtin_amdgcn_mfma_f32_16x16x32_bf16(afrag, bfrag, oacc[dg], 0, 0, 0);
                }
            }
            asm volatile("s_waitcnt lgkmcnt(0)" ::: "memory");
        }
        if (col < 4) {
            u16* orow = ACAT + (rowb + q0w + qq) * 1536;
#pragma unroll
            for (int dg = 0; dg < 4; ++dg) { u32x2 w; w.x = pk2bf(oacc[dg][0] * inv, oacc[dg][1] * inv); w.y = pk2bf(oacc[dg][2] * inv, oacc[dg][3] * inv);
                *(u32x2*)(orow + (4 * g + col) * 64 + 16 * dg + 4 * kq) = w; }
        }
    }
#undef AT_SEL
#undef AT_ISSUE_K
#undef AT_ISSUE_V
}

constexpr int HROW = 513;
constexpr int MROW = 258;
constexpr int DL_QI = 0, DL_QIH = 32 * 144  , DL_W = 9 * DL_QIH  , DL_ST = DL_W + 1024, DL_HIST = DL_ST + 512  , DL_HBYTES = 32 * HROW * 4  ,
              DL_PB = DL_HIST + DL_HBYTES, DL_END = DL_PB + 8 * 4096;
constexpr int DL_MASK = DL_HIST, DL_CCNT = DL_HIST + 16640, DL_CL = DL_HIST + 16896, DL_SELL = DL_HIST + 32768;
constexpr int DL_WV = DL_HIST;
constexpr int CAND_CAP = 32;
static_assert(3 * 10240 <= DL_W && 2 * 10240 <= 32768 && 3 * 10240 <= 8 * 4096 && DL_END <= LDS_BYTES - 64 && 32 * MROW * 2 <= 16640 && DL_CL + 32 * CAND_CAP * 8 <= DL_SELL && DL_SELL + 32768 <= DL_PB && DL_HIST % 16 == 0, "DSA LDS map");

#define FMA_ABS(I, ACC, W) do { float s_ = sc[I]; s_ = fmaf(__builtin_fabsf((ACC)[I]), (W), s_); asm volatile("" : "+v"(s_)); sc[I] = s_; } while (0)
#define ST_MFMA(ACC, SLOT) do { if (PM == 2) { _Pragma("unroll") for (int i_ = 0; i_ < 16; ++i_) ACC[i_] = (float)ta[SLOT][i_ & 3][i_ & 7]; } else { ACC = (f32x16){0.f,0.f,0.f,0.f,0.f,0.f,0.f,0.f,0.f,0.f,0.f,0.f,0.f,0.f,0.f,0.f}; _Pragma("unroll") for (int ks = 0; ks < 4; ++ks) ACC = __builtin_amdgcn_mfma_f32_32x32x16_f16(kf[ks], ta[SLOT][ks], ACC, 0, 0, 0); } } while (0)
#define ST_LOAD(SLOT, HEAD) do { _Pragma("unroll") for (int ks = 0; ks < 4; ++ks) ta[SLOT][ks] = *(const LAS half8*)(qb + (HEAD) * DL_QIH + 32 * ks); } while (0)
#define ST_FMAS(ACC, W) do { if (PM == 1) { sc[0] += ACC[0] + ACC[5] + ACC[10] + ACC[15]; } else { _Pragma("unroll") for (int i = 0; i < 16; ++i) FMA_ABS(i, ACC, W); } } while (0)
#define ST_SCHED(NLD) do { _Pragma("unroll") for (int g_ = 0; g_ < 4; ++g_) { __builtin_amdgcn_sched_group_barrier(0x008, 1, 0); if (NLD) __builtin_amdgcn_sched_group_barrier(0x100, 1, 0); __builtin_amdgcn_sched_group_barrier(0x002, 4, 0); } } while (0)
template <int PM> __device__ __forceinline__ void score_tile(LAS unsigned char* lds, const half8 (&kf)[4], const float (&wq)[8], int r, int hh, f32x16& sc) {
    int qoff = r * 144 + 16 * hh; asm volatile("" : "+v"(qoff));
    const LAS unsigned char* qb = lds + DL_QI + qoff;
    half8 ta[3][4];
    f32x16 accA, accB;
    ST_LOAD(0, 8); ST_LOAD(1, 0); ST_LOAD(2, 1);
    __builtin_amdgcn_sched_barrier(0);
    ST_MFMA(accA, 0); ST_LOAD(0, 2);
    __builtin_amdgcn_sched_barrier(0);
    ST_MFMA(accB, 1); ST_LOAD(1, 3); sc = accA;
    __builtin_amdgcn_sched_barrier(0);
    ST_MFMA(accA, 2); ST_LOAD(2, 4); ST_FMAS(accB, wq[0]); ST_SCHED(1);
    __builtin_amdgcn_sched_barrier(0);
    ST_MFMA(accB, 0); ST_LOAD(0, 5); ST_FMAS(accA, wq[1]); ST_SCHED(1);
    __builtin_amdgcn_sched_barrier(0);
    ST_MFMA(accA, 1); ST_LOAD(1, 6); ST_FMAS(accB, wq[2]); ST_SCHED(1);
    __builtin_amdgcn_sched_barrier(0);
    ST_MFMA(accB, 2); ST_LOAD(2, 7); ST_FMAS(accA, wq[3]); ST_SCHED(1);
    __builtin_amdgcn_sched_barrier(0);
    ST_MFMA(accA, 0); ST_FMAS(accB, wq[4]); ST_SCHED(0);
    __builtin_amdgcn_sched_barrier(0);
    ST_MFMA(accB, 1); ST_FMAS(accA, wq[5]); ST_SCHED(0);
    __builtin_amdgcn_sched_barrier(0);
    ST_MFMA(accA, 2); ST_FMAS(accB, wq[6]); ST_SCHED(0);
    __builtin_amdgcn_sched_barrier(0);
    ST_FMAS(accA, wq[7]);
}
__device__ __forceinline__ unsigned key16(unsigned h) { return (h ^ ((h & 0x8000u) ? 0xffffu : 0x8000u)) & 0xffffu; }
constexpr int HROW8 = 129;
template <int PASS, bool DIAG>
__device__ __forceinline__ void dsa_tile_epi(LAS unsigned char* lds, const unsigned (&hw)[8], LAS unsigned char* hb, unsigned st, int klim, int kt, int r, int hh) {
    unsigned m16 = 0u, c16 = 0u;
#pragma unroll
    for (int rgi = 0; rgi < 16; ++rgi) {
        const int rg = 15 - rgi;
        const int kr = (rg & 3) + 8 * (rg >> 2);
        const unsigned k = key16((rg & 1) ? hw[rg >> 1] >> 16 : hw[rg >> 1] & 0xffffu);
        if (PASS == 0) { unsigned val = 1u << ((k >> 4) & 16u); if (DIAG) val = kr <= klim ? val : 0u; atomicAdd((unsigned*)(hb + ((k >> 7) & 0x1fcu)), val); }
        else if (PASS == 1) { unsigned val = (k >> 8) == st ? 1u << ((k << 4) & 16u) : 0u; if (DIAG) val = kr <= klim ? val : 0u; atomicAdd((unsigned*)(hb + ((k << 1) & 0x1fcu)), val); }
        else { bool gt = k > st, eq = k == st; if (DIAG) { gt = gt && kr <= klim; eq = eq && kr <= klim; }
            m16 = (m16 << 1) | (gt ? 1u : 0u); c16 = (c16 << 1) | (eq ? 1u : 0u); }
    }
    if (PASS == 2) {
        ((LAS u16*)(lds + DL_MASK))[r * MROW + kt * 2 + hh] = (u16)m16;
        if (__builtin_expect(__ballot(c16 != 0u) != 0ull, 0)) {
#pragma unroll
            for (int rg = 0; rg < 16; ++rg) if ((c16 >> rg) & 1u) { const unsigned pp = atomicAdd((unsigned*)((LAS unsigned*)(lds + DL_CCNT) + r), 1u);
                if (pp < (unsigned)CAND_CAP) ((LAS unsigned*)(lds + DL_CL))[r * CAND_CAP + pp] = (unsigned)(kt * 32 + (rg & 3) + 8 * (rg >> 2) + 4 * hh); }
        }
    }
}
template <bool HIST>
__device__ __forceinline__ void dsa_pass_a(LAS unsigned char* lds, const u16* Z, size_t rowb, int q0, int qt, int wave, int lane, unsigned char* scr) {
    const int r = lane & 31, hh = lane >> 5;
    if (wave > qt) return;
    float wq[8];
#pragma unroll
    for (int hd = 0; hd < 8; ++hd) wq[hd] = ((const LAS float*)(lds + DL_W))[hd * 32 + r];
    LAS unsigned char* hb = lds + DL_HIST + r * (HROW8 * 4);
    half8 kf[4];
    { const u16* kp = Z + (rowb + wave * 32 + r) * ZW + KI_OFF + 8 * hh;
#pragma unroll
      for (int ks = 0; ks < 4; ++ks) kf[ks] = *(const half8*)(kp + 16 * ks); }
#pragma unroll 1
    for (int kt = wave; kt <= qt; kt += 8) {
        f32x16 sc; score_tile<0>(lds, kf, wq, r, hh, sc);
        { const int ktn = kt + 8 <= qt ? kt + 8 : kt; const u16* kp = Z + (rowb + ktn * 32 + r) * ZW + KI_OFF + 8 * hh;
#pragma unroll
          for (int ks = 0; ks < 4; ++ks) kf[ks] = *(const half8*)(kp + 16 * ks); }
        unsigned hw[8];
#pragma unroll
        for (int i = 0; i < 8; ++i) hw[i] = pk2h(sc[2 * i], sc[2 * i + 1]);
        u32x4* sp = (u32x4*)(scr + ((size_t)kt * 64 + lane) * 32);
        sp[0] = (u32x4){hw[0], hw[1], hw[2], hw[3]}; sp[1] = (u32x4){hw[4], hw[5], hw[6], hw[7]};
        if (HIST) {
            const int klim = q0 + r - kt * 32 - 4 * hh;
            if (kt == qt) dsa_tile_epi<0, true>(lds, hw, hb, 0u, klim, kt, r, hh);
            else dsa_tile_epi<0, false>(lds, hw, hb, 0u, klim, kt, r, hh);
        }
    }
    asm volatile("s_waitcnt vmcnt(0)" ::: "memory");
}
template <int PASS>
__device__ __forceinline__ void dsa_pass_bc(LAS unsigned char* lds, int q0, int qt, int wave, int lane, const unsigned char* scr) {
    const int r = lane & 31, hh = lane >> 5;
    if (wave > qt) return;
    const unsigned st = ((const LAS unsigned*)(lds + DL_ST))[r * 4 + (PASS == 1 ? 0 : 1)];
    LAS unsigned char* hb = lds + DL_HIST + r * (HROW8 * 4);
    u32x4 cur0, cur1;
    { const u32x4* sp = (const u32x4*)(scr + ((size_t)wave * 64 + lane) * 32); cur0 = __builtin_nontemporal_load(sp); cur1 = __builtin_nontemporal_load(sp + 1); }
#pragma unroll 1
    for (int kt = wave; kt <= qt; kt += 8) {
        const unsigned hw[8] = {cur0.x, cur0.y, cur0.z, cur0.w, cur1.x, cur1.y, cur1.z, cur1.w};
        { const int ktn = kt + 8 <= qt ? kt + 8 : kt; const u32x4* sp = (const u32x4*)(scr + ((size_t)ktn * 64 + lane) * 32); cur0 = __builtin_nontemporal_load(sp); cur1 = __builtin_nontemporal_load(sp + 1); }
        const int klim = q0 + r - kt * 32 - 4 * hh;
        if (kt == qt) dsa_tile_epi<PASS, true>(lds, hw, hb, st, klim, kt, r, hh);
        else dsa_tile_epi<PASS, false>(lds, hw, hb, st, klim, kt, r, hh);
    }
}
__device__ __forceinline__ void hist_find8(const LAS unsigned* hw, int r, int lane, unsigned& bin, unsigned& above_out) {
    unsigned cnt[4], tot = 0u;
#pragma unroll
    for (int i = 0; i < 2; ++i) { const unsigned w = hw[2 * lane + i]; cnt[2 * i] = w & 0xffffu; cnt[2 * i + 1] = w >> 16; tot += cnt[2 * i] + cnt[2 * i + 1]; }
    unsigned suf = tot;
#pragma unroll
    for (int o = 1; o < 64; o <<= 1) { const unsigned t = __shfl_down(suf, o); if (lane + o < 64) suf += t; }
    const unsigned above = suf - tot;
    const bool mine = (above < (unsigned)r) && ((unsigned)r <= above + tot);
    unsigned d = 0u, cb = 0u, cumv = above; bool found = false;
#pragma unroll
    for (int j = 3; j >= 0; --j) { if (!found && cumv + cnt[j] >= (unsigned)r) { d = (unsigned)(4 * lane + j); cb = cumv; found = true; } cumv += cnt[j]; }
    const unsigned long long bm = __ballot(mine);
    const int src = __ffsll((long long)bm) - 1;
    bin = (unsigned)__shfl((int)d, src); above_out = (unsigned)__shfl((int)cb, src);
}

__device__ __forceinline__ void dsa_prompt_unit(const PA p, LAS unsigned char* lds, int b, int qt) {
    const int tid = fresh_tid(p.wv), lane = tid & 63, wave = __builtin_amdgcn_readfirstlane(tid >> 6);
    unsigned char* ws = p.ws();
    const u16* Z = (const u16*)(ws + WS_Z); const float* WI = (const float*)(ws + WS_WI);
    u16* ACAT = (u16*)(ws + WS_ACAT);
    const size_t rowb = (size_t)b * SEQ; const int q0 = qt * 32;
    LAS unsigned* ST = (LAS unsigned*)(lds + DL_ST);
    __syncthreads();
    for (int pc = tid; pc < 2048; pc += 512) { const int row = pc >> 6, c = pc & 63, hd = c >> 3, d8 = c & 7;
        const u32x4 v = *(const u32x4*)(Z + (rowb + q0 + row) * ZW + QI_OFF + c * 8);
        *(LAS u32x4*)(lds + DL_QI + hd * DL_QIH + row * 144 + d8 * 16) = v; }
    if (tid < 256) {
        const int row = tid >> 3, d8 = tid & 7;
        const float* wr = WI + (rowb + q0 + row) * 8; const f32x4 wa = *(const f32x4*)wr, wb = *(const f32x4*)(wr + 4);
        const float wh[8] = {wa[0], wa[1], wa[2], wa[3], wb[0], wb[1], wb[2], wb[3]};
        float accq[8];
#pragma unroll
        for (int e = 0; e < 8; ++e) accq[e] = 0.f;
#pragma unroll
        for (int hd = 0; hd < 8; ++hd) {
            const half8 qv = *(const half8*)(Z + (rowb + q0 + row) * ZW + QI_OFF + hd * 64 + d8 * 8); const float wv = wh[hd] * (0.5f * IDX_C);
#pragma unroll
            for (int e = 0; e < 8; ++e) accq[e] = fmaf((float)qv[e], wv, accq[e]);
            if (hd == d8) ((LAS float*)(lds + DL_W))[hd * 32 + row] = wv;
        }
        half8 o;
#pragma unroll
        for (int e = 0; e < 8; ++e) o[e] = (_Float16)accq[e];
        *(LAS half8*)(lds + DL_QI + 8 * DL_QIH + row * 144 + d8 * 16) = o;
    }
    unsigned zz = 0u; asm volatile("" : "+v"(zz));
    if (tid < 32) { ST[tid * 4] = ~zz; ST[tid * 4 + 1] = zz; ST[tid * 4 + 2] = zz; ST[tid * 4 + 3] = zz; }
    const bool need_sel = q0 + 32 > TOPK;
    unsigned char* scr = ws + WS_SSC + (size_t)blockIdx.x * (32 * 4096 * 4);
    if (need_sel) { for (int i = tid; i < 32 * HROW8 * 4 / 16; i += 512) *(LAS u32x4*)(lds + DL_HIST + i * 16) = (u32x4){zz, zz, zz, zz}; }
    __syncthreads();
    if (need_sel) {
        dsa_pass_a<true>(lds, Z, rowb, q0, qt, wave, lane, scr);
        __syncthreads();
#pragma unroll 1
        for (int qq = 0; qq < 4; ++qq) { const int ql = wave * 4 + qq; unsigned bin, above; hist_find8((const LAS unsigned*)(lds + DL_HIST) + ql * HROW8, TOPK, lane, bin, above);
            if (lane == 0) { ST[ql * 4] = bin; ST[ql * 4 + 2] = (unsigned)TOPK - above; } }
        __syncthreads();
        for (int i = tid; i < 32 * HROW8 * 4 / 16; i += 512) *(LAS u32x4*)(lds + DL_HIST + i * 16) = (u32x4){zz, zz, zz, zz};
        __syncthreads();
        dsa_pass_bc<1>(lds, q0, qt, wave, lane, scr);
        __syncthreads();
#pragma unroll 1
        for (int qq = 0; qq < 4; ++qq) { const int ql = wave * 4 + qq; const unsigned r1 = ST[ql * 4 + 2]; unsigned bin, above; hist_find8((const LAS unsigned*)(lds + DL_HIST) + ql * HROW8, (int)r1, lane, bin, above);
            if (lane == 0) { ST[ql * 4 + 1] = (ST[ql * 4] << 8) | bin; ST[ql * 4 + 3] = r1 - above; } }
        __syncthreads();
    } else {
        dsa_pass_a<false>(lds, Z, rowb, q0, qt, wave, lane, scr);
    }
    for (int i = tid; i < 16896 / 16; i += 512) *(LAS u32x4*)(lds + DL_MASK + i * 16) = (u32x4){zz, zz, zz, zz};
    __syncthreads();
    dsa_pass_bc<2>(lds, q0, qt, wave, lane, scr);
    __syncthreads();
#pragma unroll 1
    for (int qq = 0; qq < 4; ++qq) {
        const int ql = wave * 4 + qq;
        LAS unsigned* sel = (LAS unsigned*)(lds + DL_SELL + wave * 4096 + qq * 1024);
        const LAS u16* mrow = (const LAS u16*)(lds + DL_MASK) + ql * MROW + 4 * lane;
        unsigned w0 = (unsigned)mrow[0] | ((unsigned)mrow[1] << 16), w1 = (unsigned)mrow[2] | ((unsigned)mrow[3] << 16);
        const int c = __popc(w0) + __popc(w1);
        int inc = c;
#pragma unroll
        for (int o = 1; o < 64; o <<= 1) { const int t = __shfl_up(inc, o); if (lane >= o) inc += t; }
        const int total = __shfl(inc, 63);
        int pos = inc - c;
        while (w0) { const int bb = __ffs((int)w0) - 1, rg = bb & 15; if (pos < TOPK) sel[pos] = (unsigned)(64 * lane + (rg & 3) + 8 * (rg >> 2) + 4 * (bb >> 4)); ++pos; w0 &= w0 - 1u; }
        while (w1) { const int bb = __ffs((int)w1) - 1, rg = bb & 15; if (pos < TOPK) sel[pos] = (unsigned)(64 * lane + 32 + (rg & 3) + 8 * (rg >> 2) + 4 * (bb >> 4)); ++pos; w1 &= w1 - 1u; }
        int cc = (int)((const LAS unsigned*)(lds + DL_CCNT))[ql]; cc = cc < CAND_CAP ? cc : CAND_CAP;
        const int r2 = (int)ST[ql * 4 + 3];
        int ntake = 0;
        if (r2 > 0 && cc > 0) {
            const unsigned xi = ((const LAS unsigned*)(lds + DL_CL))[ql * CAND_CAP + (lane < cc ? lane : 0)]; int rank = 0;
            for (int j = 0; j < cc; ++j) { const unsigned xj = (unsigned)__shfl((int)xi, j); rank += xj < xi ? 1 : 0; }
            if (lane < cc && rank < r2 && total + rank < TOPK) sel[total + rank] = xi;
            ntake = r2 < cc ? r2 : cc;
        }
        const int count = total + ntake;
        for (int i = count + lane; i < TOPK; i += 64) sel[i] = 0u;
        if (lane == 0) ST[ql * 4 + 2] = (unsigned)(count < TOPK ? count : TOPK);
    }
    asm volatile("s_waitcnt lgkmcnt(0)" ::: "memory");
    __syncthreads();
    LAS unsigned char* vst = wave < 3 ? lds + DL_QI + wave * VST_BYTES : (wave < 5 ? lds + DL_HIST + (wave - 3) * VST_BYTES : lds + DL_PB + (wave - 5) * VST_BYTES);
    REP(9) attn_wave(Z, ws + WS_K8, ws + WS_V8, rowb, q0 + wave * 4, lds + DL_SELL + wave * 4096, wave, ST, vst, ACAT, lane);
}

constexpr int GB_QT = 0, GB_KD = 17408, GB_AT = GB_KD + 18432, GB_VT = GB_AT + 9216, GB_BUF = GB_VT + 4608  , GB_ST = 2 * GB_BUF, GB_STB = 8704  , GB_DEC = GB_ST + 2 * GB_STB, GB_END = GB_DEC + 1024;
static_assert(GB_END <= LDS_BYTES, "GLA-B LDS map");
struct ChainRegs { u32x4 q[2], k[2], a, v; float d; };
__device__ __forceinline__ void chain_load(const PA p, ChainRegs& R, int cid, int h, int dvb, int tid) {
    unsigned char* ws = p.ws();
    const u16* Z = (const u16*)(ws + WS_Z); const u16* QT = (const u16*)(ws + WS_QT); const u16* KDT = (const u16*)(ws + WS_KDT); const u16* ATT = (const u16*)(ws + WS_ATT);
    const float* DEC = (const float*)(ws + WS_DEC);
    const int R0 = cid < 512 ? cid * 64 : MP + (cid - 512) * 8, nv = cid < 512 ? 64 : 8;
#pragma unroll
    for (int i = 0; i < 2; ++i) { const int pc = tid + 512 * i, row = pc >> 4, c16 = pc & 15;
        R.q[i] = row < nv ? *(const u32x4*)(QT + (size_t)(R0 + row) * 512 + h * 128 + c16 * 8) : (u32x4){0u, 0u, 0u, 0u};
        const int dk = pc >> 3, c8 = pc & 7;
        R.k[i] = *(const u32x4*)(KDT + (((size_t)cid * 4 + h) * 128 + dk) * 64 + c8 * 8); }
    R.a = *(const u32x4*)(ATT + ((size_t)cid * 4 + h) * 4096 + (tid >> 3) * 64 + (tid & 7) * 8);
    R.v = (u32x4){0u, 0u, 0u, 0u};
    if (tid < 256) { const int t = tid >> 2, c4 = tid & 3; if (t < nv) R.v = *(const u32x4*)(Z + (size_t)(R0 + t) * ZW + VB_OFF + h * 256 + dvb * 32 + c4 * 8); }
    R.d = tid < 128 ? DEC[((size_t)cid * 4 + h) * 128 + tid] : 0.f;
}
__device__ __forceinline__ void chain_store_lds(const ChainRegs& R, LAS unsigned char* buf, LAS float* dec, int tid) {
#pragma unroll
    for (int i = 0; i < 2; ++i) { const int pc = tid + 512 * i, row = pc >> 4, c16 = pc & 15;
        *(LAS u32x4*)(buf + GB_QT + row * 272 + c16 * 16) = R.q[i];
        const int dk = pc >> 3, c8 = pc & 7;
        *(LAS u32x4*)(buf + GB_KD + dk * 144 + c8 * 16) = R.k[i]; }
    *(LAS u32x4*)(buf + GB_AT + (tid >> 3) * 144 + (tid & 7) * 16) = R.a;
    if (tid < 256) { const int t = tid >> 2, c4 = tid & 3;
        const unsigned w[4] = {R.v.x, R.v.y, R.v.z, R.v.w};
#pragma unroll
        for (int e = 0; e < 8; ++e) *(LAS u16*)(buf + GB_VT + (8 * c4 + e) * 144 + t * 2) = (u16)((e & 1) ? (w[e >> 1] >> 16) : (w[e >> 1] & 0xffffu)); }
    if (tid < 128) dec[tid] = R.d;
}
__device__ __forceinline__ void gla_chain(const PA p, LAS unsigned char* lds, int cid0, int nchunks, int h, int dvb, const float* s0, float* sout) {
    const int tid = fresh_tid(p.wv), lane = tid & 63, wave = __builtin_amdgcn_readfirstlane(tid >> 6);
    const int r = lane & 31, hh = lane >> 5;
    u16* ORAW = (u16*)(p.ws() + WS_ORAW);
    f32x16 S = {};
    if (wave < 4 && s0) {
#pragma unroll
        for (int rg = 0; rg < 16; ++rg) { const int dk = 32 * wave + (rg & 3) + 8 * (rg >> 2) + 4 * hh; S[rg] = s0[(size_t)dk * 256 + dvb * 32 + r]; }
    }
    __syncthreads();
    ChainRegs RA, RB;
    chain_load(p, RA, cid0, h, dvb, tid);
    chain_store_lds(RA, lds, (LAS float*)(lds + GB_DEC), tid);
    if (nchunks > 1) chain_load(p, RA, cid0 + 1, h, dvb, tid);
    if (wave < 4) {
#pragma unroll
        for (int g4 = 0; g4 < 4; ++g4) { u32x2 w; w.x = pk2bf(S[4 * g4], S[4 * g4 + 1]); w.y = pk2bf(S[4 * g4 + 2], S[4 * g4 + 3]);
            *(LAS u32x2*)(lds + GB_ST + r * 272 + (32 * wave + 8 * g4 + 4 * hh) * 2) = w; }
    }
    __syncthreads();
#define CHAIN_STEP(C, RX, RY) do { \
        const int c_ = (C); const int cid = cid0 + c_; \
        LAS unsigned char* buf = lds + (c_ & 1) * GB_BUF; LAS unsigned char* nbuf = lds + ((c_ + 1) & 1) * GB_BUF; \
        LAS float* dec = (LAS float*)(lds + GB_DEC + (c_ & 1) * 512); LAS float* ndec = (LAS float*)(lds + GB_DEC + ((c_ + 1) & 1) * 512); \
        const LAS unsigned char* stc = lds + GB_ST + (c_ & 1) * GB_STB; LAS unsigned char* stn = lds + GB_ST + ((c_ + 1) & 1) * GB_STB;        \
        if (c_ + 2 < nchunks) chain_load(p, RY, cid + 2, h, dvb, tid); \
        if (wave < 4) {        \
            _Pragma("unroll") for (int g4 = 0; g4 < 4; ++g4) { const f32x4 d4 = *(const LAS f32x4*)(dec + 32 * wave + 8 * g4 + 4 * hh); \
                _Pragma("unroll") for (int e = 0; e < 4; ++e) S[4 * g4 + e] *= d4[e]; } \
            _Pragma("unroll") for (int ks = 0; ks < 4; ++ks) { \
                const bf16x8 a = *(const LAS bf16x8*)(buf + GB_KD + (32 * wave + r) * 144 + (16 * ks + 8 * hh) * 2); \
                const bf16x8 bv = *(const LAS bf16x8*)(buf + GB_VT + r * 144 + (16 * ks + 8 * hh) * 2); \
                S = __builtin_amdgcn_mfma_f32_32x32x16_bf16(a, bv, S, 0, 0, 0); } \
            if (c_ + 1 < nchunks) { _Pragma("unroll") for (int g4 = 0; g4 < 4; ++g4) { u32x2 w; w.x = pk2bf(S[4 * g4], S[4 * g4 + 1]); w.y = pk2bf(S[4 * g4 + 2], S[4 * g4 + 3]); \
                *(LAS u32x2*)(stn + r * 272 + (32 * wave + 8 * g4 + 4 * hh) * 2) = w; } } \
        } else { \
              \
            const int w4 = wave - 4, tt = w4 & 1, dh = w4 >> 1, r16 = lane & 15, q4 = lane >> 4, nk32 = tt + 1; \
            f32x4 o0 = {0.f, 0.f, 0.f, 0.f}, o1 = {0.f, 0.f, 0.f, 0.f}; \
            for (int ks = 0; ks < nk32; ++ks) { \
                const bf16x8 bv = *(const LAS bf16x8*)(buf + GB_VT + (16 * dh + r16) * 144 + (32 * ks + 8 * q4) * 2); \
                const bf16x8 a0 = *(const LAS bf16x8*)(buf + GB_AT + (32 * tt + r16) * 144 + (32 * ks + 8 * q4) * 2); \
                const bf16x8 a1 = *(const LAS bf16x8*)(buf + GB_AT + (32 * tt + 16 + r16) * 144 + (32 * ks + 8 * q4) * 2); \
                o0 = __builtin_amdgcn_mfma_f32_16x16x32_bf16(bv, a0, o0, 0, 0, 0); o1 = __builtin_amdgcn_mfma_f32_16x16x32_bf16(bv, a1, o1, 0, 0, 0); } \
            _Pragma("unroll") for (int ks = 0; ks < 4; ++ks) { \
                const bf16x8 bs = *(const LAS bf16x8*)(stc + (16 * dh + r16) * 272 + (32 * ks + 8 * q4) * 2); \
                const bf16x8 a0 = *(const LAS bf16x8*)(buf + GB_QT + (32 * tt + r16) * 272 + (32 * ks + 8 * q4) * 2); \
                const bf16x8 a1 = *(const LAS bf16x8*)(buf + GB_QT + (32 * tt + 16 + r16) * 272 + (32 * ks + 8 * q4) * 2); \
                o0 = __builtin_amdgcn_mfma_f32_16x16x32_bf16(bs, a0, o0, 0, 0, 0); o1 = __builtin_amdgcn_mfma_f32_16x16x32_bf16(bs, a1, o1, 0, 0, 0); } \
            const int R0 = cid < 512 ? cid * 64 : MP + (cid - 512) * 8, nv = cid < 512 ? 64 : 8; \
              \
            { const int t0 = 32 * tt + r16, t1 = t0 + 16; u32x2 w0, w1; \
              w0.x = pk2bf(o0[0], o0[1]); w0.y = pk2bf(o0[2], o0[3]); w1.x = pk2bf(o1[0], o1[1]); w1.y = pk2bf(o1[2], o1[3]); \
              if (t0 < nv) *(u32x2*)(ORAW + (size_t)(R0 + t0) * DM + h * 256 + dvb * 32 + 16 * dh + 4 * q4) = w0; \
              if (t1 < nv) *(u32x2*)(ORAW + (size_t)(R0 + t1) * DM + h * 256 + dvb * 32 + 16 * dh + 4 * q4) = w1; } \
        } \
        if (c_ + 1 < nchunks) chain_store_lds(RX, nbuf, ndec, tid); \
        __syncthreads();        \
    } while (0)
#pragma unroll 1
    for (int c = 0; c < nchunks; c += 2) {
        CHAIN_STEP(c, RA, RB);
        if (c + 1 < nchunks) CHAIN_STEP(c + 1, RB, RA);
    }
#undef CHAIN_STEP
    if (wave < 4) {
#pragma unroll
        for (int rg = 0; rg < 16; ++rg) { const int dk = 32 * wave + (rg & 3) + 8 * (rg >> 2) + 4 * hh; sout[(size_t)dk * 256 + dvb * 32 + r] = S[rg]; }
    }
}

template <int NR>
__device__ __forceinline__ void onorm_rows(const PA p, int m0, int step, int lane) {
    unsigned char* ws = p.ws();
    const u16* Z = (const u16*)(ws + WS_Z); const u16* ORAW = (const u16*)(ws + WS_ORAW); u16* ACAT = (u16*)(ws + WS_ACAT);
    const float* gn = p.in(10) + (lane & 15) * 16;
    float gnv[16];
#pragma unroll
    for (int i = 0; i < 16; ++i) gnv[i] = gn[i];
    for (int m = m0; m < MT; m += NR * step) {
        u32x4 ov[NR][2], gv[NR][2];
#pragma unroll
        for (int k = 0; k < NR; ++k) { const int row = m + k * step < MT ? m + k * step : m;
            ov[k][0] = *(const u32x4*)(ORAW + (size_t)row * DM + lane * 16); ov[k][1] = *(const u32x4*)(ORAW + (size_t)row * DM + lane * 16 + 8);
            gv[k][0] = *(const u32x4*)(Z + (size_t)row * ZW + GB_OFF + lane * 16); gv[k][1] = *(const u32x4*)(Z + (size_t)row * ZW + GB_OFF + lane * 16 + 8); }
#pragma unroll
        for (int k = 0; k < NR; ++k) {
            if (m + k * step >= MT) break;
            const int row = m + k * step;
            float o[16], gb[16];
            const unsigned ow[8] = {ov[k][0].x, ov[k][0].y, ov[k][0].z, ov[k][0].w, ov[k][1].x, ov[k][1].y, ov[k][1].z, ov[k][1].w};
            const unsigned gw[8] = {gv[k][0].x, gv[k][0].y, gv[k][0].z, gv[k][0].w, gv[k][1].x, gv[k][1].y, gv[k][1].z, gv[k][1].w};
            float ss = 0.f;
#pragma unroll
            for (int i = 0; i < 8; ++i) { o[2 * i] = bflo(ow[i]); o[2 * i + 1] = bfhi(ow[i]); gb[2 * i] = bflo(gw[i]); gb[2 * i + 1] = bfhi(gw[i]); ss += o[2 * i] * o[2 * i] + o[2 * i + 1] * o[2 * i + 1]; }
            ss += __shfl_xor(ss, 1); ss += __shfl_xor(ss, 2); ss += __shfl_xor(ss, 4); ss += __shfl_xor(ss, 8);
            const float rinv = 1.0f / sqrtf(ss * (1.0f / 256.0f) + NORM_EPS);
            unsigned w[8];
#pragma unroll
            for (int i = 0; i < 8; ++i) {
                const float a = o[2 * i] * rinv * gnv[2 * i] * (gb[2 * i] * sigmoidf_(gb[2 * i]));
                const float bq = o[2 * i + 1] * rinv * gnv[2 * i + 1] * (gb[2 * i + 1] * sigmoidf_(gb[2 * i + 1]));
                w[i] = pk2bf(a, bq);
            }
            u16* dst = ACAT + (size_t)row * 1536 + 512 + lane * 16;
            *(u32x4*)dst = (u32x4){w[0], w[1], w[2], w[3]}; *(u32x4*)(dst + 8) = (u32x4){w[4], w[5], w[6], w[7]};
        }
    }
}
__device__ __forceinline__ void ffn_colsums(const PA p, int gw, int ngw, int lane) {
    float* C1 = (float*)(p.ws() + WS_CTL + CTL_C1); float* C2 = (float*)(p.ws() + WS_CTL + CTL_C2);
    const float* W = p.in(16); const float* g1 = p.in(14); const float* b1 = p.in(15);
    for (int it = gw; it < 64 * 32; it += ngw) {
        const int cg = it & 63, ks = it >> 6, n = cg * 64 + lane;
        float s1 = 0.f, s2 = 0.f;
#pragma unroll 8
        for (int kk = 0; kk < 32; ++kk) { const int k = ks * 32 + kk; const float w = W[(size_t)k * DFF + n]; s1 = fmaf(g1[k], w, s1); s2 = fmaf(b1[k], w, s2); }
        atomicAdd(C1 + n, s1); atomicAdd(C2 + n, s2);
    }
}
template <int NR>
__device__ __forceinline__ void ln_rows(const float* src, float* dst, u16* dstb, const float* g, const float* bt, int m0, int step, int lane) {
    for (int m = m0; m < MT; m += NR * step) {
        f32x4 v[NR][4];
#pragma unroll
        for (int k = 0; k < NR; ++k) { const int mk = m + k * step < MT ? m + k * step : m; const f32x4* x4 = (const f32x4*)(src + (size_t)mk * DM) + lane;
#pragma unroll
            for (int j = 0; j < 4; ++j) v[k][j] = x4[64 * j]; }
#pragma unroll
        for (int k = 0; k < NR; ++k) {
            if (m + k * step >= MT) break;
            const size_t ro = (size_t)(m + k * step) * DM;
            float s = 0.f;
#pragma unroll
            for (int j = 0; j < 4; ++j) s += (v[k][j][0] + v[k][j][1]) + (v[k][j][2] + v[k][j][3]);
            const float mean = wave_sum(s) * (1.f / DM); float s2 = 0.f;
#pragma unroll
            for (int j = 0; j < 4; ++j) { v[k][j] = v[k][j] - mean; s2 += (v[k][j][0] * v[k][j][0] + v[k][j][1] * v[k][j][1]) + (v[k][j][2] * v[k][j][2] + v[k][j][3] * v[k][j][3]); }
            const float rstd = 1.f / sqrtf(wave_sum(s2) * (1.f / DM) + NORM_EPS);
#pragma unroll
            for (int j = 0; j < 4; ++j) {
                const f32x4 gg = *((const f32x4*)g + lane + 64 * j), bb = *((const f32x4*)bt + lane + 64 * j);
                const f32x4 y = v[k][j] * rstd * gg + bb;
                *((f32x4*)(dst + ro) + lane + 64 * j) = y;
                if (dstb) { u32x2 o; o.x = pk2bf(y[0], y[1]); o.y = pk2bf(y[2], y[3]); *((u32x2*)(dstb + ro) + lane + 64 * j) = o; }
            }
        }
    }
}

__device__ __forceinline__ void ln2_rows(const u16* VB, const float* STAT2, float* Y, const float* g, const float* bt, int m0, int step, int lane) {
    f32x4 gg[4], bb[4];
#pragma unroll
    for (int j = 0; j < 4; ++j) { gg[j] = *((const f32x4*)g + lane + 64 * j); bb[j] = *((const f32x4*)bt + lane + 64 * j); }
    for (int m = m0; m < MT; m += 4 * step) {
        u32x2 v[4][4]; f32x2_cv st[4];
#pragma unroll
        for (int k = 0; k < 4; ++k) { const int mk = m + k * step < MT ? m + k * step : m; st[k] = *(const f32x2_cv*)(STAT2 + (size_t)mk * 2);
#pragma unroll
            for (int j = 0; j < 4; ++j) v[k][j] = *((const u32x2*)(VB + (size_t)mk * DM) + lane + 64 * j); }
#pragma unroll
        for (int k = 0; k < 4; ++k) {
            if (m + k * step >= MT) break;
            const float mean = st[k][0] * (1.0f / DM), rstd = 1.0f / sqrtf(st[k][1] * (1.0f / DM) - mean * mean + NORM_EPS);
#pragma unroll
            for (int j = 0; j < 4; ++j) {
                const f32x4 x = (f32x4){bflo(v[k][j].x), bfhi(v[k][j].x), bflo(v[k][j].y), bfhi(v[k][j].y)};
                *((f32x4*)(Y + (size_t)(m + k * step) * DM) + lane + 64 * j) = (x - mean) * rstd * gg[j] + bb[j];
            }
        }
    }
}

__global__ void __launch_bounds__(512, 2) mk_fwd(Params p_unused) {
    extern __shared__ __attribute__((aligned(16))) unsigned char lds_raw[];
    LAS unsigned char* lds = (LAS unsigned char*)lds_raw;
    cg::grid_group grid = cg::this_grid();
    const PA p{(kaptr_t)__builtin_amdgcn_kernarg_segment_ptr(), __builtin_amdgcn_readfirstlane((int)threadIdx.x >> 6)};
    const int G = gridDim.x, B = blockIdx.x;
    volatile LAS unsigned* bst = (volatile LAS unsigned*)(lds + LDS_BYTES - 64);
    if (threadIdx.x < 2) bst[threadIdx.x] = 0u;
    __syncthreads();
    const XcdBarrier xbar = xcd_barrier_post(g_xbar, bst);
    const int vcu = (G % 8 == 0) ? (B % 8) * (G / 8) + B / 8 : B;
    unsigned char* ws = p.ws();
    u16* Z = (u16*)(ws + WS_Z);

    {
        unsigned* ctlw = (unsigned*)(ws + WS_CTL);
        for (unsigned i = 8192u + (unsigned)B * 512u + (unsigned)fresh_tid(p.wv); i < (unsigned)(CTL_ZERO / 4); i += (unsigned)G * 512u) ctlw[i] = 0u;
    }
    REP(10) phase_prologue(p, lds);
    if (ws == nullptr) grid.sync();
    xcd_barrier(xbar);

    REP(1) { pg8::Gemm g{(const u16*)(ws + WS_XB), (const u16*)(ws + WS_WIN), MP, ZW, DM, DM, DM}; pg8::StaticOrder S; S.init(MP, ZW, G, B);
      EpiZ E{Z, p.out(), (float*)(ws + WS_WI), (float*)(ws + WS_AB), ws + WS_K8, ws + WS_V8, ZW};
      pg8::gemm_phase<EpiZ, true>(lds, g, S, E, p.wv);
      ElZ El{Z, p.out(), (float*)(ws + WS_WI), (float*)(ws + WS_AB)};
      REP(19) mini_gemm_slab(lds, (const u16*)(ws + WS_XB) + (size_t)MP * DM, DM, (const u16*)(ws + WS_WIN), DM, ZW, DM, El, B, G, p.wv); }
    xcd_barrier(xbar);

    REP(2) for (int u = vcu; u < NCHUNK; u += G) gla_a_chunk(p, lds, u);
    REP(3) { const int tid = fresh_tid(p.wv), lane = tid & 63, wave = __builtin_amdgcn_readfirstlane(tid >> 6);
      sample_scores_phase(p, lane); }
    xcd_barrier(xbar);

    REP(4) for (int vb = B; vb < 256; vb += G) {
        const int b = vb & 7, j = vb >> 3;
#pragma unroll 1
        for (int s4 = 0; s4 < 4; ++s4) { const int qt = s4 == 0 ? j : (s4 == 1 ? 63 - j : (s4 == 2 ? 64 + j : 127 - j)); dsa_prompt_unit(p, lds, b, qt); }
    }
    __syncthreads();
    REP(5) for (int q = B; q < MS; q += G) {
        const int tid = fresh_tid(p.wv), lane = tid & 63, wave = __builtin_amdgcn_readfirstlane(tid >> 6);
        const int bs = q >> 3, t = q & 7;
        LAS unsigned* hist = (LAS unsigned*)(lds + DL_WV); LAS unsigned* sel = (LAS unsigned*)(lds + DL_WV + 8192); LAS unsigned* xch = (LAS unsigned*)(lds + DL_W);
        __syncthreads();
        int cnt = 0; REP(18) cnt = select_topk_block((const float*)(ws + WS_SSM) + (size_t)q * SSTR, PAST + t + 1, hist, sel, xch, tid);
        {
            KVSample kv{p.in(2), p.in(3), p.out() + OFF_KS + (size_t)bs * 8 * 128, p.out() + OFF_VS + (size_t)bs * 8 * 128, (const int*)p.in(6) + bs * NPAGES};
            if (tid < TOPK) sel[tid] = kv.code((int)sel[tid]);
            __syncthreads();
            LAS float* partb = (LAS float*)(lds + DL_WV + 32768);
            LAS float* pbuf = (LAS float*)(lds + DL_WV + 16384 + wave * 1024);
            sparse_attn_part<KVSample>(Z + (size_t)(MP + q) * ZW, kv, sel, 64 * (wave >> 1), pbuf, partb + ((wave & 1) * 4 + (wave >> 1)) * 264, lane, wave & 1);
            __syncthreads();
            if (wave < 2) attn_combine(partb + wave * 4 * 264, (u16*)(ws + WS_ACAT) + (size_t)(MP + q) * 1536, lane, wave);
        }
    }
    REP(6) for (int ci = vcu; ci < 256 + 1024; ci += G) {
        if (ci < 256) { const int b = ci >> 5, h = (ci >> 3) & 3, dvb = ci & 7;
            gla_chain(p, lds, b * 64, 64, h, dvb, nullptr, p.out() + OFF_GP + ((size_t)b * 4 + h) * 128 * 256); }
        else { const int c2 = ci - 256, bs = c2 >> 5, h = (c2 >> 3) & 3, dvb = c2 & 7;
            gla_chain(p, lds, 512 + bs, 1, h, dvb, p.in(5) + ((size_t)bs * 4 + h) * 128 * 256, p.out() + OFF_GS + ((size_t)bs * 4 + h) * 128 * 256); }
    }
    xcd_barrier(xbar);

    { const int tid = fresh_tid(p.wv), lane = tid & 63, wave = __builtin_amdgcn_readfirstlane(tid >> 6);
      REP(15) onorm_rows<4>(p, B * 8 + wave, G * 8, lane);
      ffn_colsums(p, B * 8 + wave, G * 8, lane); }
    xcd_barrier(xbar);

    REP(11) {
    { pg8::Gemm g{(const u16*)(ws + WS_ACAT), (const u16*)(ws + WS_WAO), MP, DM, 1536, 1536, 1536}; pg8::StaticOrder S; S.init(MP, DM, G, B);
      EpiMerge E{Z, (u16*)(ws + WS_MRG)};
      pg8::gemm_phase<EpiMerge, true>(lds, g, S, E, p.wv); }
    { ElGateA El{Z, (u16*)(ws + WS_T1)};
      mini_gemm(lds, (const u16*)(ws + WS_ACAT) + (size_t)MP * 1536, 1536, (const u16*)(ws + WS_WAO), 1536, DM, 512, El, B, G, p.wv); }
    { ElGateB El{Z, (const u16*)(ws + WS_T1), (u16*)(ws + WS_MRG)};
      mini_gemm(lds, (const u16*)(ws + WS_ACAT) + (size_t)MP * 1536 + 512, 1536, (const u16*)(ws + WS_WAO) + 512, 1536, DM, DM, El, B, G, p.wv); }
    }
    xcd_barrier(xbar);

    float* STAT = (float*)(ws + WS_CTL + CTL_STAT); const float* C1 = (const float*)(ws + WS_CTL + CTL_C1); const float* C2 = (const float*)(ws + WS_CTL + CTL_C2);
    REP(12) { pg8::Gemm g{(const u16*)(ws + WS_MRG), (const u16*)(ws + WS_WOUT), MP, DM, DM, DM, DM}; pg8::StaticOrder S; S.init(MP, DM, G, B);
      EpiU E{(const u16*)(ws + WS_XB), (u16*)(ws + WS_H1B), STAT};
      pg8::gemm_phase<EpiU, true>(lds, g, S, E, p.wv);
      ElU El{p.in(1), (u16*)(ws + WS_H1B)};
      mini_gemm<ElU, true>(lds, (const u16*)(ws + WS_MRG) + (size_t)MP * DM, DM, (const u16*)(ws + WS_WOUT), DM, DM, DM, El, B, G, p.wv, STAT); }
    xcd_barrier(xbar);

    REP(13) { pg8::Gemm g{(const u16*)(ws + WS_H1B), (const u16*)(ws + WS_WF1), MP, DFF, DM, DM, DM}; pg8::StaticOrder S; S.init(MP, DFF, G, B, 8);
      EpiRelu2LN E{(u16*)(ws + WS_F), STAT, C1, C2};
      pg8::gemm_phase<EpiRelu2LN, true>(lds, g, S, E, p.wv);
      ElRelu2LN El{(u16*)(ws + WS_F), STAT, C1, C2};
      mini_gemm_slab(lds, (const u16*)(ws + WS_H1B) + (size_t)MP * DM, DM, (const u16*)(ws + WS_WF1), DM, DFF, DM, El, B, G, p.wv); }
    xcd_barrier(xbar);

    REP(14) { pg8::Gemm g{(const u16*)(ws + WS_F), (const u16*)(ws + WS_WF2), MP, DM, DFF, DFF, DFF}; pg8::StaticOrder S; S.init(MP, DM, G, B);
      float* STAT2 = (float*)(ws + WS_CTL + CTL_STAT2);
      EpiOut E{(const u16*)(ws + WS_H1B), STAT, p.in(14), p.in(15), (u16*)(ws + WS_U), STAT2};
      pg8::gemm_phase<EpiOut, true>(lds, g, S, E, p.wv);
      ElOut El{(const u16*)(ws + WS_H1B), STAT, p.in(14), p.in(15), (u16*)(ws + WS_U)};
      mini_gemm<ElOut, true>(lds, (const u16*)(ws + WS_F) + (size_t)MP * DFF, DFF, (const u16*)(ws + WS_WF2), DFF, DM, DFF, El, B, G, p.wv, STAT2); }
    xcd_barrier(xbar);

    { const int tid = fresh_tid(p.wv), lane = tid & 63, wave = __builtin_amdgcn_readfirstlane(tid >> 6);
    ln2_rows((const u16*)(ws + WS_U), (const float*)(ws + WS_CTL + CTL_STAT2), p.out() + OFF_Y, p.in(18), p.in(19), B * 8 + wave, G * 8, lane); }
    if (fresh_tid(p.wv) == 0) {
        if (xb_add(&g_xbar[XB_EXIT], 1u) == (unsigned)G - 1u) {
            for (int j = 0; j < 16; ++j) { g_xbar[XB_XCNT(j)] = 0u; g_xbar[XB_XSUB(j)] = 0u; g_xbar[XB_XGEN(j)] = 0u; }
            g_xbar[XB_TOP] = 0u; g_xbar[XB_TOPGEN] = 0u; g_xbar[XB_TMO] = 0u; g_xbar[XB_EXIT] = 0u;
        }
    }
}

extern "C" void kernel_launch(void* const* d_in, const int* in_sizes, int n_in, void* d_out, int out_size, void* d_ws, size_t ws_size, hipStream_t stream) {
    static int grid = 0;
    if (grid == 0) {
        if (n_in != 20 || (size_t)out_size != OUT_TOTAL || ws_size < WS_END) { fprintf(stderr, "kernel_launch: unexpected shapes (n_in %d out %d ws %zu)\n", n_in, out_size, ws_size); grid = -1; return; }
        int dev = 0, cus = 0, per_cu = 0;
        if (hipGetDevice(&dev) != hipSuccess || hipDeviceGetAttribute(&cus, hipDeviceAttributeMultiprocessorCount, dev) != hipSuccess) { grid = -1; return; }
        if (hipFuncSetAttribute((const void*)mk_fwd, hipFuncAttributeMaxDynamicSharedMemorySize, LDS_BYTES) != hipSuccess) { fprintf(stderr, "kernel_launch: hipFuncSetAttribute failed\n"); grid = -1; return; }
        if (hipOccupancyMaxActiveBlocksPerMultiprocessor(&per_cu, (const void*)mk_fwd, 512, LDS_BYTES) != hipSuccess || per_cu < 1) { fprintf(stderr, "kernel_launch: occupancy query says %d\n", per_cu); (void)hipGetLastError(); grid = -1; return; }
        grid = cus;
    }
    if (grid < 0) return;
    Params p{};
    for (int i = 0; i < 20; ++i) p.in[i] = (const float*)d_in[i];
    p.out = (float*)d_out; p.ws = (unsigned char*)d_ws;
    void* args[] = {&p};
    hipError_t e = hipLaunchCooperativeKernel((const void*)mk_fwd, dim3(grid), dim3(512), args, LDS_BYTES, stream);
    if (e != hipSuccess) fprintf(stderr, "cooperative launch failed: %s (grid %d)\n", hipGetErrorString(e), grid);
}
```
